# Optimizing an MI355X kernel written in HIP

```python
import math
import jax, jax.numpy as jnp
from jax import lax
import numpy as np

D_MODEL = 1024
BATCH = 1
SEQ = 16384
DEPTH = 2
DEC_BATCH = 2
DEC_SEQ = 16384
PAST_LEN = 128

CONV_WIDTH = 512
CONV_K = 3
ATTN_HEADS = 8
HEAD_DIM = 64
ATTN_WIDTH = ATTN_HEADS * HEAD_DIM
ROPE_DIM = HEAD_DIM // 4
ROPE_THETA = 500000.0
DILATED_BRANCHES = ((128, 1), (512, 4), (2048, 16))
IN0_WIDTH = 3 * CONV_WIDTH + 3 * ATTN_WIDTH
LRU_WIDTH = D_MODEL
LRU_BLOCKS = 4
LRU_BLOCK_DIM = LRU_WIDTH // LRU_BLOCKS
LRU_CONV_K = 4
LRU_C = 8.0
D_FF = 2816
EPS = 1e-6
MASK_VALUE = -1e30

kernel_name = 'hybrid_conv_dilattn_rglru_macaron_encoder'


def _rmsnorm(x, g):
    xf = x.astype(jnp.float32)
    y = xf * lax.rsqrt(jnp.mean(xf * xf, axis=-1, keepdims=True) + EPS)
    return (y * g.astype(jnp.float32)).astype(x.dtype)


def _swiglu(x, w_gate, w_up, w_down):
    return (jax.nn.silu(x @ w_gate) * (x @ w_up)) @ w_down


def _depthwise_conv(u, w, left):
    K = w.shape[0]
    S = u.shape[1]
    up = jnp.pad(u, ((0, 0), (left, K - 1 - left), (0, 0)))
    y = up[:, 0:S] * w[0]
    for j in range(1, K):
        y = y + up[:, j:j + S] * w[j]
    return y


def _partial_rope(x, pos):
    half = ROPE_DIM // 2
    inv_freq = ROPE_THETA ** (-jnp.arange(half, dtype=jnp.float32) / half)
    ang = pos.astype(jnp.float32)[:, None] * inv_freq[None, :]
    cos = jnp.cos(ang)[None, :, None, :].astype(x.dtype)
    sin = jnp.sin(ang)[None, :, None, :].astype(x.dtype)
    x1 = x[..., :half]
    x2 = x[..., half:ROPE_DIM]
    return jnp.concatenate([x1 * cos - x2 * sin, x2 * cos + x1 * sin, x[..., ROPE_DIM:]], axis=-1)


def _band_attention(q, k, v, half_window):
    N, L, H, Dh = q.shape
    blk = half_window
    nb = -(-L // blk)
    Lp = nb * blk
    qb = jnp.pad(q, ((0, 0), (0, Lp - L), (0, 0), (0, 0))).reshape(N, nb, blk, H, Dh)
    padk = ((0, 0), (blk, Lp - L + blk), (0, 0), (0, 0))
    kr = jnp.pad(k, padk).reshape(N, nb + 2, blk, H, Dh)
    vr = jnp.pad(v, padk).reshape(N, nb + 2, blk, H, Dh)
    kb = jnp.concatenate([kr[:, :-2], kr[:, 1:-1], kr[:, 2:]], axis=2)
    vb = jnp.concatenate([vr[:, :-2], vr[:, 1:-1], vr[:, 2:]], axis=2)
    s = jnp.einsum('nbqhd,nbkhd->nbhqk', qb, kb,
                   preferred_element_type=jnp.float32) * (Dh ** -0.5)
    qpos = jnp.arange(nb)[:, None, None] * blk + jnp.arange(blk)[None, :, None]
    kpos = jnp.arange(nb)[:, None, None] * blk - blk + jnp.arange(3 * blk)[None, None, :]
    valid = (jnp.abs(kpos - qpos) <= half_window) & (kpos >= 0) & (kpos < L)
    s = jnp.where(valid[None, :, None], s, MASK_VALUE)
    m = jnp.max(s, axis=-1, keepdims=True)
    p = jnp.exp(s - m)
    den = jnp.sum(p, axis=-1, keepdims=True)
    o = jnp.einsum('nbhqk,nbkhd->nbqhd', (p / den).astype(v.dtype), vb)
    lse = (m + jnp.log(den))[..., 0]
    o = o.reshape(N, Lp, H, Dh)[:, :L]
    lse = jnp.transpose(lse, (0, 1, 3, 2)).reshape(N, Lp, H)[:, :L]
    return o, lse


def _dilated_attention(q, k, v):
    B, S, H, Dh = q.shape
    outs, lses = [], []
    for window, dil in DILATED_BRANCHES:
        L = S // dil

        def split(t):
            return t.reshape(B, L, dil, H, Dh).transpose(0, 2, 1, 3, 4).reshape(B * dil, L, H, Dh)

        o, lse = _band_attention(split(q), split(k), split(v), window // (2 * dil))
        outs.append(o.reshape(B, dil, L, H, Dh).transpose(0, 2, 1, 3, 4).reshape(B, S, H, Dh))
        lses.append(lse.reshape(B, dil, L, H).transpose(0, 2, 1, 3).reshape(B, S, H))
    w = jax.nn.softmax(jnp.stack(lses, axis=-1), axis=-1)
    o = w[..., 0:1].astype(q.dtype) * outs[0]
    for g in range(1, len(outs)):
        o = o + w[..., g:g + 1].astype(q.dtype) * outs[g]
    return o


def _conv_attn_mixer(h, pos, w_in, conv_w, w_out):
    B, S, _ = h.shape
    z = h @ w_in
    c, a = CONV_WIDTH, ATTN_WIDTH
    u, gb, gc, q, k, v = jnp.split(z, [c, 2 * c, 3 * c, 3 * c + a, 3 * c + 2 * a], axis=-1)
    ya = gb * _depthwise_conv(gc * u, conv_w, left=1)
    q = _partial_rope(q.reshape(B, S, ATTN_HEADS, HEAD_DIM), pos)
    k = _partial_rope(k.reshape(B, S, ATTN_HEADS, HEAD_DIM), pos)
    v = v.reshape(B, S, ATTN_HEADS, HEAD_DIM)
    yb = _dilated_attention(q, k, v).reshape(B, S, ATTN_WIDTH)
    return jnp.concatenate([ya, yb], axis=-1) @ w_out


def _rglru_direction(xb, w_a, b_a, w_i, b_i, lam, reverse):
    B, S, W = xb.shape
    xg = xb.reshape(B, S, LRU_BLOCKS, LRU_BLOCK_DIM)
    r = jax.nn.sigmoid((jnp.einsum('bsgi,gij->bsgj', xg, w_a).reshape(B, S, W) + b_a).astype(jnp.float32))
    i = jax.nn.sigmoid((jnp.einsum('bsgi,gij->bsgj', xg, w_i).reshape(B, S, W) + b_i).astype(jnp.float32))
    log_a = -LRU_C * r * jax.nn.softplus(-lam.astype(jnp.float32))
    a = jnp.exp(log_a)
    bterm = jnp.sqrt(-jnp.expm1(2.0 * log_a)) * i * xb.astype(jnp.float32)

    def combine(c1, c2):
        a1, b1 = c1
        a2, b2 = c2
        return a1 * a2, a2 * b1 + b2

    _, hseq = lax.associative_scan(combine, (a, bterm), reverse=reverse, axis=1)
    return hseq


def _rglru_mixer(h, w_in, conv_w, conv_b,
                 fwd_w_a, fwd_b_a, fwd_w_i, fwd_b_i, fwd_lambda,
                 bwd_w_a, bwd_b_a, bwd_w_i, bwd_b_i, bwd_lambda, w_out):
    z = h @ w_in
    xb, gate = jnp.split(z, [LRU_WIDTH], axis=-1)
    xb = _depthwise_conv(xb, conv_w, left=2) + conv_b
    hf = _rglru_direction(xb, fwd_w_a, fwd_b_a, fwd_w_i, fwd_b_i, fwd_lambda, reverse=False)
    hb = _rglru_direction(xb, bwd_w_a, bwd_b_a, bwd_w_i, bwd_b_i, bwd_lambda, reverse=True)
    y = (hf + hb).astype(h.dtype) * jax.nn.gelu(gate)
    return y @ w_out


def _trunk(x, layers, final_norm):
    pos = jnp.arange(x.shape[1], dtype=jnp.int32)
    for layer in range(DEPTH):
        p = layers[layer]
        x = x + 0.5 * _swiglu(_rmsnorm(x, p['ffn1_norm']), p['ffn1_w_gate'], p['ffn1_w_up'], p['ffn1_w_down'])
        h = _rmsnorm(x, p['mix_norm'])
        if layer % 2 == 0:
            x = x + _conv_attn_mixer(h, pos, p['w_in'], p['conv_w'], p['w_out'])
        else:
            x = x + _rglru_mixer(h, p['w_in'], p['conv_w'], p['conv_b'],
                                 p['fwd_w_a'], p['fwd_b_a'], p['fwd_w_i'], p['fwd_b_i'], p['fwd_lambda'],
                                 p['bwd_w_a'], p['bwd_b_a'], p['bwd_w_i'], p['bwd_b_i'], p['bwd_lambda'],
                                 p['w_out'])
        x = x + 0.5 * _swiglu(_rmsnorm(x, p['ffn2_norm']), p['ffn2_w_gate'], p['ffn2_w_up'], p['ffn2_w_down'])
    return _rmsnorm(x, final_norm)


def setup_inputs(seed: int = 0) -> dict:
    key = jax.random.key(seed)
    keys = jax.random.split(key, 64)
    counter = [0]

    def nk():
        counter[0] += 1
        return keys[counter[0] - 1]

    def dense(shape, fan_in):
        return jax.random.normal(nk(), shape, jnp.float32) * fan_in ** -0.5

    def gain(n):
        return 1.0 + 0.05 * jax.random.normal(nk(), (n,), jnp.float32)

    def bias(n):
        return 0.02 * jax.random.normal(nk(), (n,), jnp.float32)

    def lru_lambda(n):
        u = jax.random.uniform(nk(), (n,), jnp.float32, 0.9, 0.999)
        a = u ** (1.0 / LRU_C)
        return jnp.log(a) - jnp.log1p(-a)

    D, F = D_MODEL, D_FF
    inp = {}
    inp['x_prompt'] = jax.random.normal(nk(), (BATCH, SEQ, D), jnp.float32)
    inp['x_sample'] = jax.random.normal(nk(), (DEC_BATCH, DEC_SEQ, D), jnp.float32)
    inp['l0_ffn1_norm'] = gain(D)
    inp['l0_ffn1_w_gate'] = dense((D, F), D)
    inp['l0_ffn1_w_up'] = dense((D, F), D)
    inp['l0_ffn1_w_down'] = dense((F, D), F)
    inp['l0_mix_norm'] = gain(D)
    inp['l0_w_in'] = dense((D, IN0_WIDTH), D)
    inp['l0_conv_w'] = dense((CONV_K, CONV_WIDTH), CONV_K)
    inp['l0_w_out'] = dense((CONV_WIDTH + ATTN_WIDTH, D), CONV_WIDTH + ATTN_WIDTH)
    inp['l0_ffn2_norm'] = gain(D)
    inp['l0_ffn2_w_gate'] = dense((D, F), D)
    inp['l0_ffn2_w_up'] = dense((D, F), D)
    inp['l0_ffn2_w_down'] = dense((F, D), F)
    inp['l1_ffn1_norm'] = gain(D)
    inp['l1_ffn1_w_gate'] = dense((D, F), D)
    inp['l1_ffn1_w_up'] = dense((D, F), D)
    inp['l1_ffn1_w_down'] = dense((F, D), F)
    inp['l1_mix_norm'] = gain(D)
    inp['l1_w_in'] = dense((D, 2 * LRU_WIDTH), D)
    inp['l1_conv_w'] = dense((LRU_CONV_K, LRU_WIDTH), LRU_CONV_K)
    inp['l1_conv_b'] = bias(LRU_WIDTH)
    inp['l1_fwd_w_a'] = dense((LRU_BLOCKS, LRU_BLOCK_DIM, LRU_BLOCK_DIM), LRU_BLOCK_DIM)
    inp['l1_fwd_b_a'] = bias(LRU_WIDTH)
    inp['l1_fwd_w_i'] = dense((LRU_BLOCKS, LRU_BLOCK_DIM, LRU_BLOCK_DIM), LRU_BLOCK_DIM)
    inp['l1_fwd_b_i'] = bias(LRU_WIDTH)
    inp['l1_fwd_lambda'] = lru_lambda(LRU_WIDTH)
    inp['l1_bwd_w_a'] = dense((LRU_BLOCKS, LRU_BLOCK_DIM, LRU_BLOCK_DIM), LRU_BLOCK_DIM)
    inp['l1_bwd_b_a'] = bias(LRU_WIDTH)
    inp['l1_bwd_w_i'] = dense((LRU_BLOCKS, LRU_BLOCK_DIM, LRU_BLOCK_DIM), LRU_BLOCK_DIM)
    inp['l1_bwd_b_i'] = bias(LRU_WIDTH)
    inp['l1_bwd_lambda'] = lru_lambda(LRU_WIDTH)
    inp['l1_w_out'] = dense((LRU_WIDTH, D), LRU_WIDTH)
    inp['l1_ffn2_norm'] = gain(D)
    inp['l1_ffn2_w_gate'] = dense((D, F), D)
    inp['l1_ffn2_w_up'] = dense((D, F), D)
    inp['l1_ffn2_w_down'] = dense((F, D), F)
    inp['final_norm'] = gain(D)
    return inp


def reference(x_prompt, x_sample,
              l0_ffn1_norm, l0_ffn1_w_gate, l0_ffn1_w_up, l0_ffn1_w_down,
              l0_mix_norm, l0_w_in, l0_conv_w, l0_w_out,
              l0_ffn2_norm, l0_ffn2_w_gate, l0_ffn2_w_up, l0_ffn2_w_down,
              l1_ffn1_norm, l1_ffn1_w_gate, l1_ffn1_w_up, l1_ffn1_w_down,
              l1_mix_norm, l1_w_in, l1_conv_w, l1_conv_b,
              l1_fwd_w_a, l1_fwd_b_a, l1_fwd_w_i, l1_fwd_b_i, l1_fwd_lambda,
              l1_bwd_w_a, l1_bwd_b_a, l1_bwd_w_i, l1_bwd_b_i, l1_bwd_lambda,
              l1_w_out,
              l1_ffn2_norm, l1_ffn2_w_gate, l1_ffn2_w_up, l1_ffn2_w_down,
              final_norm):
    layer0 = {
        'ffn1_norm': l0_ffn1_norm, 'ffn1_w_gate': l0_ffn1_w_gate, 'ffn1_w_up': l0_ffn1_w_up,
        'ffn1_w_down': l0_ffn1_w_down, 'mix_norm': l0_mix_norm, 'w_in': l0_w_in,
        'conv_w': l0_conv_w, 'w_out': l0_w_out, 'ffn2_norm': l0_ffn2_norm,
        'ffn2_w_gate': l0_ffn2_w_gate, 'ffn2_w_up': l0_ffn2_w_up, 'ffn2_w_down': l0_ffn2_w_down,
    }
    layer1 = {
        'ffn1_norm': l1_ffn1_norm, 'ffn1_w_gate': l1_ffn1_w_gate, 'ffn1_w_up': l1_ffn1_w_up,
        'ffn1_w_down': l1_ffn1_w_down, 'mix_norm': l1_mix_norm, 'w_in': l1_w_in,
        'conv_w': l1_conv_w, 'conv_b': l1_conv_b,
        'fwd_w_a': l1_fwd_w_a, 'fwd_b_a': l1_fwd_b_a, 'fwd_w_i': l1_fwd_w_i,
        'fwd_b_i': l1_fwd_b_i, 'fwd_lambda': l1_fwd_lambda,
        'bwd_w_a': l1_bwd_w_a, 'bwd_b_a': l1_bwd_b_a, 'bwd_w_i': l1_bwd_w_i,
        'bwd_b_i': l1_bwd_b_i, 'bwd_lambda': l1_bwd_lambda,
        'w_out': l1_w_out, 'ffn2_norm': l1_ffn2_norm,
        'ffn2_w_gate': l1_ffn2_w_gate, 'ffn2_w_up': l1_ffn2_w_up, 'ffn2_w_down': l1_ffn2_w_down,
    }
    layers = [layer0, layer1]
    y_prompt = _trunk(x_prompt, layers, final_norm)
    y_sample = _trunk(x_sample, layers, final_norm)
    return (y_prompt, y_sample)
```

```cpp
#include <hip/hip_runtime.h>
#include <hip/hip_cooperative_groups.h>
#include <cstdio>
#include <cstdint>
namespace cg = cooperative_groups;

#ifndef MK_N_LAUNCHES
#define MK_N_LAUNCHES 1
#endif

constexpr int T_TOK = 49152, SEQ = 16384, DM = 1024, DFF = 2816, Z0W = 3072;
constexpr float EPS = 1e-6f;

constexpr size_t MiB = 1u << 20;
constexpr size_t WS_ROPE = 1 * MiB;
constexpr size_t WS_SSQ = 2 * MiB;
constexpr size_t WS_W = 6 * MiB;
constexpr size_t WS_FFN_STRIDE = 17 * MiB;
constexpr size_t WS_W1T_OFF = 0, WS_W2T_OFF = 11 * MiB;
constexpr size_t WS_L0WIN = 74 * MiB, WS_L0WOUT = 80 * MiB, WS_L1WIN = 82 * MiB, WS_L1WOUT = 86 * MiB, WS_GATES = 88 * MiB;
constexpr size_t WS_XB = 92 * MiB;
constexpr size_t WS_ML = 188 * MiB;
constexpr size_t WS_BIG = 192 * MiB;
constexpr size_t WS_END = 480 * MiB;

namespace pg8 {
#define PG8_LAS __attribute__((address_space(3)))
typedef unsigned short bf16_t;
typedef short bf16x8 __attribute__((ext_vector_type(8)));
typedef float f32x4 __attribute__((ext_vector_type(4)));
typedef unsigned u32x4 __attribute__((ext_vector_type(4)));
constexpr int BM = 256, BK = 64, HALF = 128, HTB = HALF * BK * 2  , STAGE_BYTES = 8 * HTB, NXCD = 8, WGM = 8;

__host__ __device__ __forceinline__ int lds_byte(int r, int c) { const int st = (r >> 4) * 2 + (c >> 5), rr = r & 15, cc = c & 31, ob = rr * 64 + cc * 2; return st * 1024 + (ob ^ (((ob >> 9) & 1) << 5)); }
__host__ __device__ __forceinline__ void stage_rc(int b, int& R, int& C) { const int st = b / 1024, sb = b % 1024, swz = sb ^ (((sb >> 9) & 1) << 5); R = (st >> 1) * 16 + swz / 64; C = (st & 1) * 32 + (swz % 64) / 2; }
__host__ __device__ __forceinline__ int perm32(int rho) { const int n = rho >> 4, i = rho & 15; return 8 * (i >> 2) + 4 * n + (i & 3); }

struct Unit { int pm, pn; };
struct Gemm { const bf16_t* A; const bf16_t* Bt; int M, N, K, lda, ash, astride; };

struct StaticOrder {
    int nM, nN, nwg, G, c;
    __host__ __device__ void init(int M, int N, int G_, int c_) { nM = M / BM; nN = N / BM; nwg = nM * nN; G = G_; c = c_; }
    __host__ __device__ bool next(int i, Unit& u) const {
        const long L = (long)i * G + c; if (L >= nwg) return false;
        int wgid = (int)L; { const int q = nwg / NXCD, r = nwg % NXCD, xcd = wgid % NXCD, off = wgid / NXCD; wgid = (xcd < r ? xcd * (q + 1) : r * (q + 1) + (xcd - r) * q) + off; }
        const int nig = WGM * nN, gid = wgid / nig, fm = gid * WGM, gsz = (nM - fm) < WGM ? (nM - fm) : WGM;
        u.pm = fm + ((wgid % nig) % gsz); u.pn = (wgid % nig) / gsz; return true;
    }
    __device__ __forceinline__ void a_ready(const Unit&) const {}
    __device__ __forceinline__ void done(const Unit&) const {}
};

__device__ __forceinline__ unsigned cvt_pk_bf16(float lo, float hi) { unsigned r; asm("v_cvt_pk_bf16_f32 %0, %1, %2" : "=v"(r) : "v"(lo), "v"(hi)); return r; }

typedef float f32x2 __attribute__((ext_vector_type(2)));
typedef unsigned u32x2 __attribute__((ext_vector_type(2)));
__device__ __forceinline__ float bf2f(unsigned short b) { return __uint_as_float((unsigned)b << 16); }
__device__ __forceinline__ float bflo(unsigned w) { return __uint_as_float(w << 16); }
__device__ __forceinline__ float bfhi(unsigned w) { return __uint_as_float(w & 0xffff0000u); }
__device__ __forceinline__ float row_rstd(const float* SSQ, int row) {
    const f32x4* p = (const f32x4*)(SSQ + (size_t)row * 16);
    const f32x4 a = p[0], b = p[1], c = p[2], d = p[3];
    const float s = ((a[0] + a[1]) + (a[2] + a[3])) + ((b[0] + b[1]) + (b[2] + b[3])) + ((c[0] + c[1]) + (c[2] + c[3])) + ((d[0] + d[1]) + (d[2] + d[3]));
    return __builtin_amdgcn_rsqf(s * (1.0f / 1024.0f) + 1e-6f);
}
__device__ __forceinline__ float fast_sigmoid(float x) { return __builtin_amdgcn_rcpf(1.0f + __builtin_amdgcn_exp2f(-1.4426950408889634f * x)); }
__device__ __forceinline__ float silu_f(float x) { return x * fast_sigmoid(x); }
__device__ __forceinline__ float gelu_tanh_f(float x) {
    const float t = x * __builtin_fmaf(x * x, -0.1029432395800235f, -2.302208198144325f); return x * __builtin_amdgcn_rcpf(1.0f + __builtin_amdgcn_exp2f(t)); }
__device__ __forceinline__ float softplus_neg(float lam) { const float x = __expf(-lam); return (x < 0.03f) ? x * (1.0f - x * (0.5f - x * (0.33333333f - 0.25f * x))) : __logf(1.0f + x); }
template <int CTRL> __device__ __forceinline__ float dppz(float v) {
    return __int_as_float(__builtin_amdgcn_update_dpp(0, __float_as_int(v), CTRL, 0xF, 0xF, true));
}
template <int CTRL> __device__ __forceinline__ float dppf(float old, float v) {
    return __int_as_float(__builtin_amdgcn_update_dpp(__float_as_int(old), __float_as_int(v), CTRL, 0xF, 0xF, false));
}

struct EpiGateUp {
    static constexpr bool PERM = true, AFTER_DRAIN = false, APERM = false;
    bf16_t* H; const float* SSQ; const PG8_LAS float* RT; const PG8_LAS int* PML;
    __device__ __forceinline__ void operator()(f32x4 (&acc)[2][2][4][2], const Unit& u, int wr, int wc, int fr, int fq) const {
        const int row0 = u.pm * BM + wr * 64 + fr; const int col0 = u.pn * 128 + wc * 32 + 8 * fq;
        int slot = -1;
#pragma unroll
        for (int k = 0; k < 8; ++k) slot = (PML[k] == u.pm) ? k : slot;
        float rsv[2][4];
#pragma unroll
        for (int ai = 0; ai < 2; ++ai)
#pragma unroll
            for (int m = 0; m < 4; ++m) rsv[ai][m] = (slot >= 0) ? RT[slot * 256 + ai * HALF + wr * 64 + m * 16 + fr] : row_rstd(SSQ, row0 + ai * HALF + m * 16);
#pragma unroll
        for (int ai = 0; ai < 2; ++ai)
#pragma unroll
            for (int m = 0; m < 4; ++m) {
                const int row = row0 + ai * HALF + m * 16; const float rs = rsv[ai][m]; const float rsl = rs * -1.4426950408889634f, rs2 = rs * rs;
                float h[8];
#pragma unroll
                for (int n = 0; n < 2; ++n)
#pragma unroll
                    for (int e = 0; e < 4; ++e) { const float ag = acc[ai][0][m][n][e], au = acc[ai][1][m][n][e];
                        const float r = __builtin_amdgcn_rcpf(1.0f + __builtin_amdgcn_exp2f(ag * rsl)); h[4 * n + e] = ((ag * au) * rs2) * r; }
                u32x4 w; w.x = cvt_pk_bf16(h[0], h[1]); w.y = cvt_pk_bf16(h[2], h[3]); w.z = cvt_pk_bf16(h[4], h[5]); w.w = cvt_pk_bf16(h[6], h[7]);
                *(u32x4*)(H + (size_t)row * 2816 + col0) = w;
            }
    }
};

template <bool FROM_INPUT> struct EpiResidT {
    static constexpr bool PERM = true, AFTER_DRAIN = false, APERM = false;
    bf16_t* XB; float* SSQ; float scale; const float* X0; const float* X1;
    __device__ __forceinline__ void operator()(f32x4 (&acc)[2][2][4][2], const Unit& u, int wr, int wc, int fr, int fq) const {
        const int row0 = u.pm * BM + wr * 64 + fr; const int col0 = u.pn * BM + wc * 32 + 8 * fq;
#pragma unroll
        for (int ai = 0; ai < 2; ++ai) {
            f32x4 xv[4][2][2];
#pragma unroll
            for (int m = 0; m < 4; ++m) {
                const int row = row0 + ai * HALF + m * 16;
                if (FROM_INPUT) {
                    const float* xs = (row < 16384 ? X0 + (size_t)row * 1024 : X1 + (size_t)(row - 16384) * 1024) + col0;
#pragma unroll
                    for (int bj = 0; bj < 2; ++bj) { xv[m][bj][0] = *(const f32x4*)(xs + bj * HALF); xv[m][bj][1] = *(const f32x4*)(xs + bj * HALF + 4); }
                } else {
#pragma unroll
                    for (int bj = 0; bj < 2; ++bj) { const u32x4 w = *(const u32x4*)(XB + (size_t)row * 1024 + col0 + bj * HALF);
                        xv[m][bj][0] = (f32x4){bflo(w.x), bfhi(w.x), bflo(w.y), bfhi(w.y)}; xv[m][bj][1] = (f32x4){bflo(w.z), bfhi(w.z), bflo(w.w), bfhi(w.w)}; }
                }
            }
#pragma unroll
            for (int m = 0; m < 4; ++m) {
                const int row = row0 + ai * HALF + m * 16; float ss = 0.f;
#pragma unroll
                for (int bj = 0; bj < 2; ++bj) {
                    const f32x4 x0 = xv[m][bj][0] + acc[ai][bj][m][0] * scale, x1 = xv[m][bj][1] + acc[ai][bj][m][1] * scale;
                    ss += (x0[0] * x0[0] + x0[1] * x0[1]) + (x0[2] * x0[2] + x0[3] * x0[3]) + (x1[0] * x1[0] + x1[1] * x1[1]) + (x1[2] * x1[2] + x1[3] * x1[3]);
                    u32x4 w; w.x = cvt_pk_bf16(x0[0], x0[1]); w.y = cvt_pk_bf16(x0[2], x0[3]); w.z = cvt_pk_bf16(x1[0], x1[1]); w.w = cvt_pk_bf16(x1[2], x1[3]);
                    *(u32x4*)(XB + (size_t)row * 1024 + col0 + bj * HALF) = w;
                }
                ss += __shfl_xor(ss, 16); ss += __shfl_xor(ss, 32);
                if (fq == 0) SSQ[(size_t)row * 16 + u.pn * 4 + wc] = ss;
            }
        }
    }
};
typedef EpiResidT<false> EpiResid;
typedef EpiResidT<true> EpiResidIn;

struct EpiZ0 {
    static constexpr bool PERM = true, AFTER_DRAIN = false, APERM = false;
    bf16_t* Z; const float* SSQ; const PG8_LAS float* RT; const PG8_LAS int* PML; const float* ROPE; bf16_t* KH; bf16_t* VH;
    __device__ __forceinline__ void operator()(f32x4 (&acc)[2][2][4][2], const Unit& u, int wr, int wc, int fr, int fq) const {
        const int row0 = u.pm * BM + wr * 64 + fr; const int col0 = u.pn * BM + wc * 32 + 8 * fq;
        const bool rope = (u.pn >= 6) && (u.pn <= 9) && ((wc & 1) == 0);
        int slot = -1;
#pragma unroll
        for (int k = 0; k < 8; ++k) slot = (PML[k] == u.pm) ? k : slot;
        float rsv[2][4];
#pragma unroll
        for (int ai = 0; ai < 2; ++ai)
#pragma unroll
            for (int m = 0; m < 4; ++m) rsv[ai][m] = (slot >= 0) ? RT[slot * 256 + ai * HALF + wr * 64 + m * 16 + fr] : row_rstd(SSQ, row0 + ai * HALF + m * 16);
        f32x4 bc0 = {1.f, 1.f, 1.f, 1.f}, bc1 = bc0, bs0 = {0.f, 0.f, 0.f, 0.f}, bs1 = bs0;
        if (rope) { const f32x4* rp = (const f32x4*)(ROPE + (size_t)(row0 & (SEQ - 1)) * 16); bc0 = rp[0]; bc1 = rp[1]; bs0 = rp[2]; bs1 = rp[3]; }
        const f32x4 C16a = {-9.576594803e-01f, -9.992462593e-01f, 8.243765146e-01f, 9.932003012e-01f}, C16b = {9.997440109e-01f, 9.999903729e-01f, 9.999996380e-01f, 9.999999864e-01f};
        const f32x4 S16a = {-2.879033167e-01f, 3.881898152e-02f, 5.660418378e-01f, 1.164180468e-01f}, S16b = {2.262548617e-02f, 4.387956730e-03f, 8.509272408e-04f, 1.650141653e-04f};
        const f32x4 C128a = {-6.928958219e-01f, 9.521412243e-01f, 1.010104153e-01f, 5.950559312e-01f}, C128b = {9.836606904e-01f, 9.993839261e-01f, 9.999768296e-01f, 9.999991287e-01f};
        const f32x4 S128a = {7.210377105e-01f, -3.056584516e-01f, -9.948853683e-01f, 8.036842905e-01f}, S128b = {1.800323475e-01f, 3.509655735e-02f, 6.807366171e-03f, 1.320112945e-03f};
        f32x4 c0 = bc0, c1 = bc1, s0 = bs0, s1 = bs1;
#pragma unroll
        for (int ai = 0; ai < 2; ++ai)
#pragma unroll
            for (int m = 0; m < 4; ++m) {
                const int row = row0 + ai * HALF + m * 16; const float rs = rsv[ai][m];
                if (rope) {
                    if (m == 0 && ai == 1) { c0 = bc0 * C128a - bs0 * S128a; s0 = bs0 * C128a + bc0 * S128a; c1 = bc1 * C128b - bs1 * S128b; s1 = bs1 * C128b + bc1 * S128b; }
                    else if (m > 0) { const f32x4 t0 = c0 * C16a - s0 * S16a, t1 = c1 * C16b - s1 * S16b; s0 = s0 * C16a + c0 * S16a; s1 = s1 * C16b + c1 * S16b; c0 = t0; c1 = t1; }
                }
#pragma unroll
                for (int bj = 0; bj < 2; ++bj) {
                    f32x4 v0 = acc[ai][bj][m][0] * rs, v1 = acc[ai][bj][m][1] * rs;
                    if (rope) {
                        f32x4 p0, p1;
#pragma unroll
                        for (int e = 0; e < 4; ++e) { p0[e] = __shfl_xor(v0[e], 16); p1[e] = __shfl_xor(v1[e], 16); }
                        const float sg = (fq == 0) ? -1.f : 1.f;
                        if (fq < 2) { v0 = v0 * c0 + p0 * s0 * sg; v1 = v1 * c1 + p1 * s1 * sg; }
                    }
                    u32x4 w; w.x = cvt_pk_bf16(v0[0], v0[1]); w.y = cvt_pk_bf16(v0[2], v0[3]); w.z = cvt_pk_bf16(v1[0], v1[1]); w.w = cvt_pk_bf16(v1[2], v1[3]);
                    if (u.pn >= 8) {
                        const int cc = col0 + bj * HALF - 2048, hd = (cc & 511) >> 6, d0 = cc & 63;
                        bf16_t* dst = (cc < 512 ? KH : VH) + ((size_t)((row >> 14) * 8 + hd) * SEQ + (row & (SEQ - 1))) * 64 + d0;
                        *(u32x4*)dst = w;
                    } else *(u32x4*)(Z + (size_t)row * 3072 + col0 + bj * HALF) = w;
                }
            }
    }
};

struct EpiZ1 {
    static constexpr bool PERM = true, AFTER_DRAIN = false, APERM = false;
    bf16_t* XP; bf16_t* GG; const float* SSQ; const PG8_LAS float* RT; const PG8_LAS int* PML;
    __device__ __forceinline__ void operator()(f32x4 (&acc)[2][2][4][2], const Unit& u, int wr, int wc, int fr, int fq) const {
        const int row0 = u.pm * BM + wr * 64 + fr; const bool gate = u.pn >= 4;
        bf16_t* base = gate ? GG : XP; const int col0 = (u.pn & 3) * BM + wc * 32 + 8 * fq;
        int slot = -1;
#pragma unroll
        for (int k = 0; k < 8; ++k) slot = (PML[k] == u.pm) ? k : slot;
        float rsv[2][4];
#pragma unroll
        for (int ai = 0; ai < 2; ++ai)
#pragma unroll
            for (int m = 0; m < 4; ++m) rsv[ai][m] = (slot >= 0) ? RT[slot * 256 + ai * HALF + wr * 64 + m * 16 + fr] : row_rstd(SSQ, row0 + ai * HALF + m * 16);
#pragma unroll
        for (int ai = 0; ai < 2; ++ai)
#pragma unroll
            for (int m = 0; m < 4; ++m) {
                const int row = row0 + ai * HALF + m * 16; const float rs = rsv[ai][m];
#pragma unroll
                for (int bj = 0; bj < 2; ++bj) {
                    f32x4 v0 = acc[ai][bj][m][0] * rs, v1 = acc[ai][bj][m][1] * rs;
                    if (gate) {
#pragma unroll
                        for (int e = 0; e < 4; ++e) { v0[e] = gelu_tanh_f(v0[e]); v1[e] = gelu_tanh_f(v1[e]); }
                    }
                    u32x4 w; w.x = cvt_pk_bf16(v0[0], v0[1]); w.y = cvt_pk_bf16(v0[2], v0[3]); w.z = cvt_pk_bf16(v1[0], v1[1]); w.w = cvt_pk_bf16(v1[2], v1[3]);
                    *(u32x4*)(base + (size_t)row * 1024 + col0 + bj * HALF) = w;
                }
            }
    }
};

struct EpiLru {
    static constexpr bool PERM = true, AFTER_DRAIN = false, APERM = true;
    const bf16_t* XBC; bf16_t* PF; bf16_t* PB; bf16_t* SS; float* CS;
    const float *ba_f, *bi_f, *lam_f, *ba_b, *bi_b, *lam_b;
    template <int DIR>
    __device__ __forceinline__ void one_dir(f32x4 (&acc)[2][2][4][2], const Unit& u, int wr, int fr, int ch0, const u32x2 (&xin)[2][4], f32x4 ba, f32x4 bi, f32x4 sp) const {
#pragma unroll
        for (int ai = 0; ai < 2; ++ai) {
            __builtin_amdgcn_sched_barrier(0);
            const int rowb = u.pm * BM + ai * HALF + wr * 64; const int chunk = rowb >> 6;
            const unsigned ro = (unsigned)(rowb + 4 * fr) * 1024u + (unsigned)ch0;
#pragma unroll
            for (int m = 0; m < 4; ++m) {
                const u32x2 xv = xin[ai][m];
                const float x[4] = {bflo(xv.x), bfhi(xv.x), bflo(xv.y), bfhi(xv.y)};
#pragma unroll
                for (int e = 0; e < 4; ++e) {
                    const float r = __builtin_amdgcn_rcpf(1.0f + __builtin_amdgcn_exp2f(__builtin_fmaf(acc[ai][DIR][m][0][e], -1.4426950408889634f, ba[e])));
                    const float ig = __builtin_amdgcn_rcpf(1.0f + __builtin_amdgcn_exp2f(__builtin_fmaf(acc[ai][DIR][m][1][e], -1.4426950408889634f, bi[e])));
                    const float av = __builtin_amdgcn_exp2f(r * sp[e]);
                    acc[ai][DIR][m][0][e] = av; acc[ai][DIR][m][1][e] = __builtin_amdgcn_sqrtf(__builtin_fmaf(-av, av, 1.0f)) * ig * x[e];
                }
            }
            __builtin_amdgcn_sched_barrier(0);
#pragma unroll
            for (int mm = 1; mm < 4; ++mm) {
                const int m = DIR ? 3 - mm : mm, mp = DIR ? m + 1 : m - 1;
                acc[ai][DIR][m][1] = acc[ai][DIR][m][0] * acc[ai][DIR][mp][1] + acc[ai][DIR][m][1];
                acc[ai][DIR][m][0] = acc[ai][DIR][m][0] * acc[ai][DIR][mp][0];
            }
            f32x4 IP = acc[ai][DIR][DIR ? 0 : 3][0], IS = acc[ai][DIR][DIR ? 0 : 3][1];
#pragma unroll
            for (int e = 0; e < 4; ++e) {
                float p = IP[e], s = IS[e], pp, sq;
                if (DIR == 0) {
                    pp = dppf<0x111>(1.f, p); sq = dppz<0x111>(s); s = p * sq + s; p = p * pp;
                    pp = dppf<0x112>(1.f, p); sq = dppz<0x112>(s); s = p * sq + s; p = p * pp;
                    pp = dppf<0x114>(1.f, p); sq = dppz<0x114>(s); s = p * sq + s; p = p * pp;
                    pp = dppf<0x118>(1.f, p); sq = dppz<0x118>(s); s = p * sq + s; p = p * pp;
                } else {
                    pp = dppf<0x101>(1.f, p); sq = dppz<0x101>(s); s = p * sq + s; p = p * pp;
                    pp = dppf<0x102>(1.f, p); sq = dppz<0x102>(s); s = p * sq + s; p = p * pp;
                    pp = dppf<0x104>(1.f, p); sq = dppz<0x104>(s); s = p * sq + s; p = p * pp;
                    pp = dppf<0x108>(1.f, p); sq = dppz<0x108>(s); s = p * sq + s; p = p * pp;
                }
                IP[e] = p; IS[e] = s;
            }
            if (fr == (DIR ? 0 : 15)) { float* cs = CS + ((unsigned)chunk * 4096u + (unsigned)(DIR * 2048 + ch0)); *(f32x4*)(cs) = IP; *(f32x4*)(cs + 1024) = IS; }
            f32x4 EP, ES;
#pragma unroll
            for (int e = 0; e < 4; ++e) { EP[e] = DIR ? dppf<0x101>(1.f, IP[e]) : dppf<0x111>(1.f, IP[e]); ES[e] = DIR ? dppz<0x101>(IS[e]) : dppz<0x111>(IS[e]); }
#pragma unroll
            for (int m = 0; m < 4; ++m) {
                const f32x4 pf = acc[ai][DIR][m][0] * EP, sf = acc[ai][DIR][m][0] * ES + acc[ai][DIR][m][1];
                u32x2 w; w.x = cvt_pk_bf16(pf[0], pf[1]); w.y = cvt_pk_bf16(pf[2], pf[3]);
                *(u32x2*)((DIR ? PB : PF) + (ro + 1024u * m)) = w;
                if (DIR == 0) acc[ai][0][m][1] = sf;
                else { const f32x4 ssum = acc[ai][0][m][1] + sf; u32x2 v; v.x = cvt_pk_bf16(ssum[0], ssum[1]); v.y = cvt_pk_bf16(ssum[2], ssum[3]); *(u32x2*)(SS + (ro + 1024u * m)) = v; }
            }
        }
    }
    __device__ __forceinline__ void operator()(f32x4 (&acc)[2][2][4][2], const Unit& u, int wr, int wc, int fr, int fq) const {
        const int g = u.pn >> 2, sub = u.pn & 3;
        const int ch0 = 256 * g + 64 * sub + 16 * wc + 4 * fq;
        u32x2 xin[2][4];
#pragma unroll
        for (int ai = 0; ai < 2; ++ai)
#pragma unroll
            for (int m = 0; m < 4; ++m) xin[ai][m] = *(const u32x2*)(XBC + ((unsigned)(u.pm * BM + ai * HALF + wr * 64 + 4 * fr + m) * 1024u + (unsigned)ch0));
        f32x4 baf = *(const f32x4*)(ba_f + ch0), bif = *(const f32x4*)(bi_f + ch0), spf = *(const f32x4*)(lam_f + ch0);
        f32x4 bab = *(const f32x4*)(ba_b + ch0), bib = *(const f32x4*)(bi_b + ch0), spb = *(const f32x4*)(lam_b + ch0);
#pragma unroll
        for (int e = 0; e < 4; ++e) { spf[e] = (-8.0f * 1.4426950408889634f) * softplus_neg(spf[e]); baf[e] *= -1.4426950408889634f; bif[e] *= -1.4426950408889634f;
                                      spb[e] = (-8.0f * 1.4426950408889634f) * softplus_neg(spb[e]); bab[e] *= -1.4426950408889634f; bib[e] *= -1.4426950408889634f; }
        one_dir<0>(acc, u, wr, fr, ch0, xin, baf, bif, spf);
        __builtin_amdgcn_sched_barrier(0);
        one_dir<1>(acc, u, wr, fr, ch0, xin, bab, bib, spb);
    }
};


template <class Epi, class Sched, bool ALIGN_EPI = false, bool SP2 = false>
__device__ __forceinline__ void gemm_phase(PG8_LAS unsigned char* lds, const Gemm g, const Sched& S, const Epi& E) {
    const int tid = threadIdx.x, wid = __builtin_amdgcn_readfirstlane(tid >> 6), lane = tid & 63, wr = wid >> 2, wc = wid & 3, fr = lane & 15, fq = lane >> 4;
    const int K = g.K, nt = K / BK;
    unsigned voffA[2], voffB[2];
#pragma unroll
    for (int i = 0; i < 2; ++i) { int R, C; stage_rc(tid * 16 + i * 8192, R, C); const int Rb = Epi::PERM ? ((R & ~31) + perm32(R & 31)) : R;
        const int Ra = Epi::APERM ? ((R & 64) + 4 * (R & 15) + ((R >> 4) & 3)) : R; voffA[i] = (unsigned)(Ra * g.lda + C) * 2u; voffB[i] = (unsigned)(Rb * K + C) * 2u; }
    const size_t kstep = (size_t)(BK * 2);
    const size_t hstepB = (size_t)HALF * K * 2, hstepA = (size_t)HALF * g.lda * 2;
    const size_t tstepB = 2 * hstepB, tstepA = 2 * hstepA;
    const unsigned ldsw = (unsigned)wid * 1024u;
    const int aoff = lds_byte(wr * 64 + fr, fq * 8), boff = lds_byte(wc * 32 + fr, fq * 8);
#define PG8_SA(b, h) (((b) * 2 + (h)) * HTB)
#define PG8_SB(b, h) ((4 + (b) * 2 + (h)) * HTB)
#define PG8_STAGE(bufoff, gbase, voff) do { _Pragma("unroll") for (int _i = 0; _i < 2; ++_i) \
        __builtin_amdgcn_global_load_lds((const unsigned*)((const char*)(gbase) + (voff)[_i]), (PG8_LAS unsigned*)(lds + (bufoff) + ldsw + _i * 8192), 16, 0, 0); } while (0)
#define PG8_LDA(dst, b, h) do { _Pragma("unroll") for (int m = 0; m < 4; ++m) _Pragma("unroll") for (int k = 0; k < 2; ++k) dst[m][k] = *(const PG8_LAS bf16x8*)(lds + PG8_SA(b, h) + aoff + m * 2048 + k * 1024); } while (0)
#define PG8_LDB(dst, b, h) do { _Pragma("unroll") for (int n = 0; n < 2; ++n) _Pragma("unroll") for (int k = 0; k < 2; ++k) dst[n][k] = *(const PG8_LAS bf16x8*)(lds + PG8_SB(b, h) + boff + n * 2048 + k * 1024); } while (0)
#define PG8_MMA(ai, bj, At, Bt) do { __builtin_amdgcn_s_setprio(1); _Pragma("unroll") for (int m = 0; m < 4; ++m) _Pragma("unroll") for (int n = 0; n < 2; ++n) _Pragma("unroll") for (int k = 0; k < 2; ++k) \
        acc[ai][bj][m][n] = __builtin_amdgcn_mfma_f32_16x16x32_bf16(Bt[n][k], At[m][k], acc[ai][bj][m][n], 0, 0, 0); __builtin_amdgcn_s_setprio(0); } while (0)
#define PG8_WAIT_V(n) asm volatile("s_waitcnt vmcnt(" #n ")" ::: "memory")
#define PG8_WAIT_L(n) asm volatile("s_waitcnt lgkmcnt(" #n ")" ::: "memory")
#define PG8_BAR __builtin_amdgcn_s_barrier()
#define PG8_SCHED __builtin_amdgcn_sched_barrier(0)
    Unit cur, nxt; int ui = 0;
    if (!S.next(0, cur)) return;
    f32x4 acc[2][2][4][2];
#pragma unroll
    for (int a = 0; a < 2; ++a)
#pragma unroll
        for (int b = 0; b < 2; ++b)
#pragma unroll
            for (int m = 0; m < 4; ++m)
#pragma unroll
                for (int n = 0; n < 2; ++n) acc[a][b][m][n] = (f32x4){0.f, 0.f, 0.f, 0.f};
    bf16x8 At[4][2], B0[2][2], B1[2][2];
    const char* cA = (const char*)g.A + (size_t)cur.pm * tstepA + (size_t)(cur.pn >> g.ash) * (size_t)g.astride; const char* cB = (const char*)g.Bt + (size_t)cur.pn * tstepB;
    S.a_ready(cur);
    if constexpr (SP2) {
        PG8_STAGE(PG8_SB(0, 0), cB, voffB); PG8_STAGE(PG8_SB(0, 1), cB + hstepB, voffB); PG8_STAGE(PG8_SA(0, 0), cA, voffA); PG8_STAGE(PG8_SA(0, 1), cA + hstepA, voffA);
        if (wr == 1) PG8_BAR;
        PG8_WAIT_V(2); PG8_BAR;
        PG8_STAGE(PG8_SB(1, 0), cB + kstep, voffB); PG8_STAGE(PG8_SA(1, 0), cA + kstep, voffA); PG8_STAGE(PG8_SB(1, 1), cB + hstepB + kstep, voffB);
        PG8_WAIT_V(6); PG8_BAR;
    } else {
        PG8_STAGE(PG8_SB(0, 0), cB, voffB); PG8_STAGE(PG8_SA(0, 0), cA, voffA); PG8_STAGE(PG8_SB(0, 1), cB + hstepB, voffB); PG8_STAGE(PG8_SA(0, 1), cA + hstepA, voffA);
        if (wr == 1) PG8_BAR;
        PG8_WAIT_V(4); PG8_BAR;
        PG8_STAGE(PG8_SB(1, 0), cB + kstep, voffB); PG8_STAGE(PG8_SA(1, 0), cA + kstep, voffA); PG8_STAGE(PG8_SB(1, 1), cB + hstepB + kstep, voffB);
        PG8_WAIT_V(6); PG8_BAR;
    }
    for (;;) {
        const bool has_next = S.next(ui + 1, nxt);
        const char* nA = has_next ? (const char*)g.A + (size_t)nxt.pm * tstepA + (size_t)(nxt.pn >> g.ash) * (size_t)g.astride : cA; const char* nB = has_next ? (const char*)g.Bt + (size_t)nxt.pn * tstepB : cB;
        _Pragma("nounroll") for (int t = 0; t < nt; t += 2) {
            const bool last = (t == nt - 2);
            const char* a1 = cA + (size_t)(t + 1) * kstep;
            const char* a2 = last ? nA : cA + (size_t)(t + 2) * kstep; const char* b2 = last ? nB : cB + (size_t)(t + 2) * kstep;
            const char* a3 = a2 + kstep; const char* b3 = b2 + kstep;
            if (last && has_next) S.a_ready(nxt);
            if constexpr (SP2) {
            PG8_LDB(B0, 0, 0); PG8_LDB(B1, 0, 1); PG8_SCHED; PG8_LDA(At, 0, 0); PG8_STAGE(PG8_SA(1, 1), a1 + hstepA, voffA);
            PG8_WAIT_V(8); PG8_WAIT_L(0); PG8_BAR; PG8_MMA(0, 0, At, B0); PG8_MMA(0, 1, At, B1); PG8_BAR; PG8_SCHED;
            PG8_LDA(At, 0, 1); PG8_STAGE(PG8_SB(0, 0), b2, voffB); PG8_STAGE(PG8_SB(0, 1), b2 + hstepB, voffB); PG8_STAGE(PG8_SA(0, 0), a2, voffA);
            PG8_WAIT_V(8); PG8_WAIT_L(0); PG8_BAR; PG8_MMA(1, 0, At, B0); PG8_MMA(1, 1, At, B1); PG8_BAR; PG8_SCHED;
            PG8_LDB(B0, 1, 0); PG8_LDB(B1, 1, 1); PG8_SCHED; PG8_LDA(At, 1, 0); PG8_STAGE(PG8_SA(0, 1), a2 + hstepA, voffA);
            PG8_WAIT_V(8); PG8_WAIT_L(0); PG8_BAR; PG8_MMA(0, 0, At, B0); PG8_MMA(0, 1, At, B1); PG8_BAR; PG8_SCHED;
            PG8_LDA(At, 1, 1); PG8_STAGE(PG8_SB(1, 0), b3, voffB); PG8_STAGE(PG8_SB(1, 1), b3 + hstepB, voffB); PG8_STAGE(PG8_SA(1, 0), a3, voffA);
            PG8_WAIT_V(8); PG8_WAIT_L(0); PG8_BAR; PG8_MMA(1, 0, At, B0); PG8_MMA(1, 1, At, B1); PG8_BAR; PG8_SCHED;
            } else {
            PG8_LDB(B0, 0, 0); PG8_SCHED; PG8_LDA(At, 0, 0); PG8_STAGE(PG8_SA(1, 1), a1 + hstepA, voffA);
            PG8_WAIT_L(8); PG8_BAR; PG8_WAIT_L(0); PG8_MMA(0, 0, At, B0); PG8_BAR; PG8_SCHED;
            PG8_LDB(B1, 0, 1); PG8_STAGE(PG8_SB(0, 0), b2, voffB);
            PG8_BAR; PG8_WAIT_L(0); PG8_MMA(0, 1, At, B1); PG8_BAR;
            PG8_LDA(At, 0, 1); PG8_STAGE(PG8_SA(0, 0), a2, voffA);
            PG8_BAR; PG8_WAIT_L(0); PG8_MMA(1, 0, At, B0); PG8_BAR; PG8_SCHED;
            PG8_STAGE(PG8_SB(0, 1), b2 + hstepB, voffB);
            PG8_WAIT_V(6); PG8_BAR; PG8_MMA(1, 1, At, B1); PG8_BAR;
            PG8_LDB(B0, 1, 0); PG8_SCHED; PG8_LDA(At, 1, 0); PG8_STAGE(PG8_SA(0, 1), a2 + hstepA, voffA);
            PG8_WAIT_L(8); PG8_BAR; PG8_WAIT_L(0); PG8_MMA(0, 0, At, B0); PG8_BAR; PG8_SCHED;
            PG8_LDB(B1, 1, 1); PG8_STAGE(PG8_SB(1, 0), b3, voffB);
            PG8_BAR; PG8_WAIT_L(0); PG8_MMA(0, 1, At, B1); PG8_BAR;
            PG8_LDA(At, 1, 1); PG8_STAGE(PG8_SA(1, 0), a3, voffA);
            PG8_BAR; PG8_WAIT_L(0); PG8_MMA(1, 0, At, B0); PG8_BAR; PG8_SCHED;
            PG8_STAGE(PG8_SB(1, 1), b3 + hstepB, voffB);
            PG8_WAIT_V(6); PG8_BAR; PG8_MMA(1, 1, At, B1); PG8_BAR;
            }
        }
        if constexpr (ALIGN_EPI) { if (wr == 0) PG8_BAR; }
        if constexpr (!Epi::AFTER_DRAIN) { E(acc, cur, wr, wc, fr, fq); S.done(cur); }
        if (!has_next) break;
#pragma unroll
        for (int a = 0; a < 2; ++a)
#pragma unroll
            for (int b = 0; b < 2; ++b)
#pragma unroll
                for (int m = 0; m < 4; ++m)
#pragma unroll
                    for (int n = 0; n < 2; ++n) acc[a][b][m][n] = (f32x4){0.f, 0.f, 0.f, 0.f};
        cur = nxt; cA = nA; cB = nB; ++ui;
        if constexpr (ALIGN_EPI) { if (wr == 1) PG8_BAR; }
    }
    PG8_WAIT_V(0);
    if constexpr (!ALIGN_EPI) { if (wr == 0) PG8_BAR; }
    PG8_BAR;
    if constexpr (Epi::AFTER_DRAIN) { E.fused(acc, cur, wr, wc, fr, fq, lds, wid, lane); S.done(cur); }
#undef PG8_SA
#undef PG8_SB
#undef PG8_STAGE
#undef PG8_LDA
#undef PG8_LDB
#undef PG8_MMA
#undef PG8_WAIT_V
#undef PG8_WAIT_L
#undef PG8_BAR
#undef PG8_SCHED
}
}


#define LAS __attribute__((address_space(3)))
using pg8::bf16_t; using pg8::bf16x8; using pg8::f32x4; using pg8::u32x4; using pg8::f32x2; using pg8::u32x2; using pg8::cvt_pk_bf16; using pg8::bflo; using pg8::bfhi;
typedef short s16x4 __attribute__((ext_vector_type(4)));
typedef short v4i16_t __attribute__((ext_vector_type(4)));
constexpr int NTHREADS = 512, NWAVES = 8;
constexpr int RING_BYTES = 131072, LDS_BYTES = 147456;
#define LDS_WAIT() asm volatile("s_waitcnt lgkmcnt(0)" ::: "memory")

__device__ __forceinline__ float wave_sum(float v) {
#pragma unroll
    for (int o = 1; o < 64; o <<= 1) v += __shfl_xor(v, o);
    return v;
}

template <class RowMap>
__device__ __forceinline__ void transpose_item(const float* W, int N, int K, const float* gain, bf16_t* WT, RowMap rm, LAS float* scr, int kb, int nb, int lane) {
    const int k0 = 64 * kb, n0 = 32 * nb;
    float v[32];
#pragma unroll
    for (int i = 0; i < 32; ++i) { const int kk = 2 * i + (lane >> 5); v[i] = W[(size_t)(k0 + kk) * N + n0 + (lane & 31)]; }
    if (gain) {
        float gv[32];
#pragma unroll
        for (int i = 0; i < 32; ++i) gv[i] = gain[k0 + 2 * i + (lane >> 5)];
#pragma unroll
        for (int i = 0; i < 32; ++i) v[i] *= gv[i];
    }
#pragma unroll
    for (int i = 0; i < 32; ++i) { const int kk = 2 * i + (lane >> 5); scr[kk * 33 + (lane & 31)] = v[i]; }
    LDS_WAIT(); asm volatile("" ::: "memory");
    const int c = lane & 7;
#pragma unroll
    for (int j = 0; j < 4; ++j) { const int n = (lane >> 3) + 8 * j; const LAS float* s = scr + (8 * c) * 33 + n;
        u32x4 o; o.x = cvt_pk_bf16(s[0 * 33], s[1 * 33]); o.y = cvt_pk_bf16(s[2 * 33], s[3 * 33]); o.z = cvt_pk_bf16(s[4 * 33], s[5 * 33]); o.w = cvt_pk_bf16(s[6 * 33], s[7 * 33]);
        *(u32x4*)(WT + (size_t)rm(n0 + n) * K + k0 + 8 * c) = o; }
    LDS_WAIT(); asm volatile("" ::: "memory");
}
struct RmId { __device__ __forceinline__ int operator()(int n) const { return n; } };
struct RmGateUp { int off; __device__ __forceinline__ int operator()(int n) const { return 256 * (n >> 7) + (n & 127) + off; } };
struct RmWin0 { __device__ __forceinline__ int operator()(int n) const { return (n >= 512 && n < 1024) ? n + 512 : ((n >= 1024 && n < 1536) ? n - 512 : n); } };
struct RmLruGate { int g, gate; __device__ __forceinline__ int operator()(int n) const {
    return (4 * g + (n >> 6)) * 256 + 128 * (gate >> 1) + 32 * ((n >> 4) & 3) + 8 * ((n >> 2) & 3) + 4 * (gate & 1) + (n & 3); } };

struct Args { const float* in[38]; float* out; unsigned char* ws; int ph_lo, ph_hi; };

__device__ __forceinline__ void convert_items(const Args& a, LAS unsigned char* lds, int it_lo, int it_hi, int w, int nw, int wave, int lane) {
    unsigned char* ws = a.ws;
    LAS float* scr = (LAS float*)(lds + wave * 16384);
    constexpr int I_GU = 16 * 88, I_DN = 44 * 32, I_FFN = 2 * I_GU + I_DN;
    constexpr int I_WIN0 = 16 * 96, I_SQ = 16 * 32, I_WIN1 = 16 * 64, I_GATE = 4 * 8;
    constexpr int NITEMS = 4 * I_FFN + I_WIN0 + I_SQ + I_WIN1 + I_SQ + 16 * I_GATE;
    for (int it = it_lo + w; it < it_hi; it += nw) {
        int r = it;
        if (r < 4 * I_FFN) {
            const int f = r / I_FFN; r -= f * I_FFN;
            const float* nrm = (f == 0) ? a.in[2] : (f == 1) ? a.in[10] : (f == 2) ? a.in[14] : a.in[33];
            const float* wg = (f == 0) ? a.in[3] : (f == 1) ? a.in[11] : (f == 2) ? a.in[15] : a.in[34];
            const float* wu = (f == 0) ? a.in[4] : (f == 1) ? a.in[12] : (f == 2) ? a.in[16] : a.in[35];
            const float* wd = (f == 0) ? a.in[5] : (f == 1) ? a.in[13] : (f == 2) ? a.in[17] : a.in[36];
            bf16_t* W1t = (bf16_t*)(ws + WS_W + f * WS_FFN_STRIDE + WS_W1T_OFF); bf16_t* W2t = (bf16_t*)(ws + WS_W + f * WS_FFN_STRIDE + WS_W2T_OFF);
            if (r < I_GU) { transpose_item(wg, DFF, DM, nrm, W1t, RmGateUp{0}, scr, r / 88, r % 88, lane); continue; } r -= I_GU;
            if (r < I_GU) { transpose_item(wu, DFF, DM, nrm, W1t, RmGateUp{128}, scr, r / 88, r % 88, lane); continue; } r -= I_GU;
            transpose_item(wd, DM, DFF, nullptr, W2t, RmId{}, scr, r / 32, r % 32, lane); continue;
        }
        r -= 4 * I_FFN;
        if (r < I_WIN0) { transpose_item(a.in[7], Z0W, DM, a.in[6], (bf16_t*)(ws + WS_L0WIN), RmWin0{}, scr, r / 96, r % 96, lane); continue; } r -= I_WIN0;
        if (r < I_SQ) { transpose_item(a.in[9], DM, DM, nullptr, (bf16_t*)(ws + WS_L0WOUT), RmId{}, scr, r / 32, r % 32, lane); continue; } r -= I_SQ;
        if (r < I_WIN1) { transpose_item(a.in[19], 2048, DM, a.in[18], (bf16_t*)(ws + WS_L1WIN), RmId{}, scr, r / 64, r % 64, lane); continue; } r -= I_WIN1;
        if (r < I_SQ) { transpose_item(a.in[32], DM, DM, nullptr, (bf16_t*)(ws + WS_L1WOUT), RmId{}, scr, r / 32, r % 32, lane); continue; } r -= I_SQ;
        {
            const int mat = r / I_GATE; r -= mat * I_GATE;
            const int gate = mat >> 2, g = mat & 3;
            const float* src = (gate == 0) ? a.in[22] : (gate == 1) ? a.in[24] : (gate == 2) ? a.in[27] : a.in[29];
            transpose_item(src + (size_t)g * 65536, 256, 256, nullptr, (bf16_t*)(ws + WS_GATES), RmLruGate{g, gate}, scr, r / 8, r % 8, lane);
        }
    }
}

__device__ __forceinline__ void prologue(const Args& a, LAS unsigned char* lds, int gw, int ngw, int wave, int lane) {
    unsigned char* ws = a.ws;
    {
        float* R = (float*)(ws + WS_ROPE);
        for (int idx = gw * 64 + lane; idx < SEQ * 8; idx += ngw * 64) {
            const int pos = idx >> 3, i = idx & 7;
            const double f = (i == 0) ? 1.0 : (i == 1) ? 0.19392274474868576 : (i == 2) ? 0.03760603093086393 : (i == 3) ? 0.007292664737217109 :
                             (i == 4) ? 0.001414213562373095 : (i == 5) ? 0.0002742481756762073 : (i == 6) ? 5.318295896944988e-05 : 1.031338537721246e-05;
            const float ang = (float)pos * (float)f;
            double rev = (double)ang * 0.15915494309189535; rev -= floor(rev);
            const float rv = (float)rev;
            R[pos * 16 + i] = __builtin_amdgcn_cosf(rv); R[pos * 16 + 8 + i] = __builtin_amdgcn_sinf(rv);
        }
    }
    convert_items(a, lds, 0, 4224, gw, ngw, wave, lane);
    bf16_t* XB = (bf16_t*)(ws + WS_XB); float* SSQ = (float*)(ws + WS_SSQ);
    for (int row = 2 * gw; row < T_TOK; row += 2 * ngw) {
        f32x4 v[2][4]; float s[2];
#pragma unroll
        for (int q = 0; q < 2; ++q) { const int rw = row + q; const float* src = (rw < SEQ) ? a.in[0] + (size_t)rw * DM : a.in[1] + (size_t)(rw - SEQ) * DM;
            const f32x4* xr = (const f32x4*)src + lane;
#pragma unroll
            for (int j = 0; j < 4; ++j) v[q][j] = xr[64 * j]; }
#pragma unroll
        for (int q = 0; q < 2; ++q) { s[q] = 0.f;
#pragma unroll
            for (int j = 0; j < 4; ++j) s[q] += (v[q][j][0] * v[q][j][0] + v[q][j][1] * v[q][j][1]) + (v[q][j][2] * v[q][j][2] + v[q][j][3] * v[q][j][3]);
            s[q] = wave_sum(s[q]); }
#pragma unroll
        for (int q = 0; q < 2; ++q) { const int rw = row + q; u32x2* bo = (u32x2*)(XB + (size_t)rw * DM) + lane;
#pragma unroll
            for (int j = 0; j < 4; ++j) { u32x2 w; w.x = cvt_pk_bf16(v[q][j][0], v[q][j][1]); w.y = cvt_pk_bf16(v[q][j][2], v[q][j][3]); bo[64 * j] = w; }
            if (lane < 16) SSQ[(size_t)rw * 16 + lane] = (lane == 0) ? s[q] : 0.f; }
    }
}

__device__ __forceinline__ void conv_gate0(bf16_t* Z, const float* cw, int gtid, int nthr) {
    const int c8 = (gtid & 63) * 8;
    f32x4 w[3][2];
#pragma unroll
    for (int j = 0; j < 3; ++j) { w[j][0] = *(const f32x4*)(cw + j * 512 + c8); w[j][1] = *(const f32x4*)(cw + j * 512 + c8 + 4); }
    for (int idx = gtid; idx < T_TOK * 64; idx += nthr) {
        const int row = idx >> 6, pos = row & (SEQ - 1);
        u32x4 uu[3], gc[3];
#pragma unroll
        for (int j = 0; j < 3; ++j) { const int t = pos + j - 1; const int rr = row + ((t < 0) ? 0 : (t >= SEQ) ? 0 : j - 1);
            const bf16_t* zr = Z + (size_t)rr * Z0W; uu[j] = *(const u32x4*)(zr + c8); gc[j] = *(const u32x4*)(zr + 512 + c8); }
        bf16_t* gp = Z + (size_t)row * Z0W + 1024 + c8;
        const u32x4 gb = *(const u32x4*)gp;
        float acc[8] = {0.f, 0.f, 0.f, 0.f, 0.f, 0.f, 0.f, 0.f};
#pragma unroll
        for (int j = 0; j < 3; ++j) {
            const int t = pos + j - 1; const float mk = (t >= 0 && t < SEQ) ? 1.f : 0.f;
            const f32x4 w0 = w[j][0] * mk, w1 = w[j][1] * mk;
            acc[0] += w0[0] * (bflo(uu[j].x) * bflo(gc[j].x)); acc[1] += w0[1] * (bfhi(uu[j].x) * bfhi(gc[j].x));
            acc[2] += w0[2] * (bflo(uu[j].y) * bflo(gc[j].y)); acc[3] += w0[3] * (bfhi(uu[j].y) * bfhi(gc[j].y));
            acc[4] += w1[0] * (bflo(uu[j].z) * bflo(gc[j].z)); acc[5] += w1[1] * (bfhi(uu[j].z) * bfhi(gc[j].z));
            acc[6] += w1[2] * (bflo(uu[j].w) * bflo(gc[j].w)); acc[7] += w1[3] * (bfhi(uu[j].w) * bfhi(gc[j].w));
        }
        u32x4 o;
        o.x = cvt_pk_bf16(bflo(gb.x) * acc[0], bfhi(gb.x) * acc[1]); o.y = cvt_pk_bf16(bflo(gb.y) * acc[2], bfhi(gb.y) * acc[3]);
        o.z = cvt_pk_bf16(bflo(gb.z) * acc[4], bfhi(gb.z) * acc[5]); o.w = cvt_pk_bf16(bflo(gb.w) * acc[6], bfhi(gb.w) * acc[7]);
        *(u32x4*)gp = o;
    }
}

__device__ __forceinline__ void conv1(const bf16_t* XP, bf16_t* XBC, const float* cw, const float* cb, int gtid, int nthr) {
    const int c8 = (gtid & 127) * 8;
    f32x4 w[4][2];
#pragma unroll
    for (int j = 0; j < 4; ++j) { w[j][0] = *(const f32x4*)(cw + j * 1024 + c8); w[j][1] = *(const f32x4*)(cw + j * 1024 + c8 + 4); }
    const f32x4 b0 = *(const f32x4*)(cb + c8), b1 = *(const f32x4*)(cb + c8 + 4);
    for (int idx = gtid; idx < T_TOK * 128; idx += nthr) {
        const int row = idx >> 7, pos = row & (SEQ - 1);
        u32x4 xv[4];
#pragma unroll
        for (int j = 0; j < 4; ++j) { const int t = pos + j - 2; const int rr = row + ((t < 0) ? 0 : (t >= SEQ) ? 0 : j - 2); xv[j] = *(const u32x4*)(XP + (size_t)rr * DM + c8); }
        float acc[8] = {b0[0], b0[1], b0[2], b0[3], b1[0], b1[1], b1[2], b1[3]};
#pragma unroll
        for (int j = 0; j < 4; ++j) {
            const int t = pos + j - 2; const float mk = (t >= 0 && t < SEQ) ? 1.f : 0.f;
            const f32x4 w0 = w[j][0] * mk, w1 = w[j][1] * mk;
            acc[0] += w0[0] * bflo(xv[j].x); acc[1] += w0[1] * bfhi(xv[j].x); acc[2] += w0[2] * bflo(xv[j].y); acc[3] += w0[3] * bfhi(xv[j].y);
            acc[4] += w1[0] * bflo(xv[j].z); acc[5] += w1[1] * bfhi(xv[j].z); acc[6] += w1[2] * bflo(xv[j].w); acc[7] += w1[3] * bfhi(xv[j].w);
        }
        u32x4 o; o.x = cvt_pk_bf16(acc[0], acc[1]); o.y = cvt_pk_bf16(acc[2], acc[3]); o.z = cvt_pk_bf16(acc[4], acc[5]); o.w = cvt_pk_bf16(acc[6], acc[7]);
        *(u32x4*)(XBC + (size_t)row * DM + c8) = o;
    }
}

__device__ __forceinline__ void lru_carry(const float* CS, float* H0, LAS unsigned char* lds, int tid) {
    LAS float* gP = (LAS float*)lds; LAS float* gS = gP + 512;
    const int grp = tid >> 5, c = tid & 31;
    for (int u = blockIdx.x; u < 3 * 2 * 32; u += gridDim.x) {
        const int b = u / 64, dir = (u >> 5) & 1, ch = (u & 31) * 32 + c;
        float P = 1.f, S = 0.f; float pv[16], sv[16];
#pragma unroll
        for (int i = 0; i < 16; ++i) { const int o = grp * 16 + i, chunk = b * 256 + (dir ? 255 - o : o);
            pv[i] = CS[(size_t)chunk * 4096 + (dir * 2) * 1024 + ch]; sv[i] = CS[(size_t)chunk * 4096 + (dir * 2 + 1) * 1024 + ch]; }
#pragma unroll
        for (int i = 0; i < 16; ++i) { S = pv[i] * S + sv[i]; P = pv[i] * P; }
        gP[tid] = P; gS[tid] = S;
        __syncthreads();
        float h = 0.f;
        for (int g2 = 0; g2 < grp; ++g2) h = gP[g2 * 32 + c] * h + gS[g2 * 32 + c];
#pragma unroll
        for (int i = 0; i < 16; ++i) { const int o = grp * 16 + i, chunk = b * 256 + (dir ? 255 - o : o);
            H0[(size_t)chunk * 2048 + dir * 1024 + ch] = h; h = pv[i] * h + sv[i]; }
        __syncthreads();
    }
}

__device__ __forceinline__ void lru_apply(const bf16_t* PF, const bf16_t* PB, bf16_t* SS, const bf16_t* GG, const float* H0, int gtid, int nthr) {
    for (int idx = gtid; idx < T_TOK * 128; idx += nthr) {
        const int row = idx >> 7, c8 = (idx & 127) * 8; const unsigned o = (unsigned)row * 1024u + (unsigned)c8;
        const u32x4 pf = *(const u32x4*)(PF + o), pb = *(const u32x4*)(PB + o), ss = *(const u32x4*)(SS + o), gg = *(const u32x4*)(GG + o);
        const float* h0 = H0 + ((unsigned)(row >> 6) * 2048u + (unsigned)c8);
        const f32x4 f0 = *(const f32x4*)h0, f1 = *(const f32x4*)(h0 + 4), b0 = *(const f32x4*)(h0 + 1024), b1 = *(const f32x4*)(h0 + 1028);
        u32x4 y;
        y.x = cvt_pk_bf16((bflo(ss.x) + bflo(pf.x) * f0[0] + bflo(pb.x) * b0[0]) * bflo(gg.x), (bfhi(ss.x) + bfhi(pf.x) * f0[1] + bfhi(pb.x) * b0[1]) * bfhi(gg.x));
        y.y = cvt_pk_bf16((bflo(ss.y) + bflo(pf.y) * f0[2] + bflo(pb.y) * b0[2]) * bflo(gg.y), (bfhi(ss.y) + bfhi(pf.y) * f0[3] + bfhi(pb.y) * b0[3]) * bfhi(gg.y));
        y.z = cvt_pk_bf16((bflo(ss.z) + bflo(pf.z) * f1[0] + bflo(pb.z) * b1[0]) * bflo(gg.z), (bfhi(ss.z) + bfhi(pf.z) * f1[1] + bfhi(pb.z) * b1[1]) * bfhi(gg.z));
        y.w = cvt_pk_bf16((bflo(ss.w) + bflo(pf.w) * f1[2] + bflo(pb.w) * b1[2]) * bflo(gg.w), (bfhi(ss.w) + bfhi(pf.w) * f1[3] + bfhi(pb.w) * b1[3]) * bfhi(gg.w));
        *(u32x4*)(SS + o) = y;
    }
}

__device__ __forceinline__ void final_norm(const bf16_t* XB, float* OUT, const float* gain, int gw, int ngw, int lane) {
    f32x4 gv[2];
#pragma unroll
    for (int j = 0; j < 2; ++j) gv[j] = ((const f32x4*)gain)[2 * lane + j];
    f32x4 gw2[2];
#pragma unroll
    for (int j = 0; j < 2; ++j) gw2[j] = ((const f32x4*)gain)[128 + 2 * lane + j];
    for (int row = gw; row < T_TOK; row += ngw) {
        const u32x4 w0 = *((const u32x4*)(XB + (size_t)row * DM) + lane), w1 = *((const u32x4*)(XB + (size_t)row * DM + 512) + lane);
        f32x4 v[4] = {{bflo(w0.x), bfhi(w0.x), bflo(w0.y), bfhi(w0.y)}, {bflo(w0.z), bfhi(w0.z), bflo(w0.w), bfhi(w0.w)},
                      {bflo(w1.x), bfhi(w1.x), bflo(w1.y), bfhi(w1.y)}, {bflo(w1.z), bfhi(w1.z), bflo(w1.w), bfhi(w1.w)}};
        float s = 0.f;
#pragma unroll
        for (int j = 0; j < 4; ++j) s += (v[j][0] * v[j][0] + v[j][1] * v[j][1]) + (v[j][2] * v[j][2] + v[j][3] * v[j][3]);
        s = wave_sum(s);
        const float rs = 1.0f / sqrtf(s * (1.0f / 1024.0f) + EPS);
        f32x4* o = (f32x4*)(OUT + (size_t)row * DM);
        o[2 * lane] = v[0] * rs * gv[0]; o[2 * lane + 1] = v[1] * rs * gv[1];
        o[128 + 2 * lane] = v[2] * rs * gw2[0]; o[128 + 2 * lane + 1] = v[3] * rs * gw2[1];
    }
}

constexpr int APITCH = 144, AROWS = 272;
__device__ __forceinline__ s16x4 vtr(const LAS unsigned char* p) { return __builtin_bit_cast(s16x4, __builtin_amdgcn_ds_read_tr16_b64_v4i16((LAS v4i16_t*)p)); }

#define ATT_DECODE(uu, h_, tokbase_, n0_) const int h_ = (uu) & 7; const int j_##h_ = (uu) >> 3; const int b_##h_ = j_##h_ >> 7, blk_##h_ = j_##h_ & 127; \
        const int tokbase_ = b_##h_ * SEQ + blk_##h_ / NBR; const int n0_ = (blk_##h_ % NBR) * 128;
#define ATT_LOAD(h_, tokbase_, n0_) do { _Pragma("unroll") for (int i = 0; i < 4; ++i) { const int n = (n0_) - 64 + srow + 64 * i; \
        if (n >= 0 && n < L) { const int tk_ = (tokbase_) + n * DIL; const size_t o_ = ((size_t)((tk_ >> 14) * 8 + (h_)) * SEQ + (tk_ & (SEQ - 1))) * 64 + 8 * sch; kreg[i] = *(const u32x4*)(KH + o_); vreg[i] = *(const u32x4*)(VH + o_); } \
        else { kreg[i] = (u32x4){0u, 0u, 0u, 0u}; vreg[i] = (u32x4){0u, 0u, 0u, 0u}; } } } while (0)
#define ATT_LOADQ(h_, tokbase_, n0_) do { const size_t qt_ = (size_t)((tokbase_) + ((n0_) + 16 * wid + fr) * DIL); const bf16_t* qp_ = Z + qt_ * Z0W + 1536 + 64 * (h_); \
        Qn0 = *(const bf16x8*)(qp_ + 8 * fq); Qn1 = *(const bf16x8*)(qp_ + 32 + 8 * fq); \
        if (!FIRST) { mln = *(const f32x2*)(ML + qt_ * 16 + 2 * (h_)); _Pragma("unroll") for (int dt = 0; dt < 4; ++dt) on[dt] = *(const f32x4*)(OACC + qt_ * 512 + 64 * (h_) + 16 * dt + 4 * fq); } } while (0)

#define ATT_REGS u32x4 (&kreg)[4], u32x4 (&vreg)[4], bf16x8& Qn0, bf16x8& Qn1, f32x4 (&on)[4], f32x2& mln
template <int DIL, bool FIRST>
__device__ __forceinline__ void attn_prefetch(bf16_t* Z, const bf16_t* KH, const bf16_t* VH, float* OACC, float* ML, int wid, int fr, int fq, int srow, int sch, ATT_REGS, int uu) {
    constexpr int L = SEQ / DIL, NBR = 128 / DIL;
    ATT_DECODE(uu, h0, tb0, n00) ATT_LOAD(h0, tb0, n00); ATT_LOADQ(h0, tb0, n00);
}
template <int DIL, bool FIRST, bool LAST>
__device__ __forceinline__ void attn_unit(LAS unsigned char* Ks, LAS unsigned char* Vs, bf16_t* Z, const bf16_t* KH, const bf16_t* VH, float* OACC, float* ML,
                                          int wid, int fr, int fq, int srow, int sch, ATT_REGS, int u, int un, bool hn) {
    constexpr int L = SEQ / DIL, NBR = 128 / DIL;
        __syncthreads();
#pragma unroll
        for (int i = 0; i < 4; ++i) { *(LAS u32x4*)(Ks + (srow + 64 * i) * APITCH + 16 * sch) = kreg[i]; *(LAS u32x4*)(Vs + (srow + 64 * i) * APITCH + 16 * sch) = vreg[i]; }
        __syncthreads();
        ATT_DECODE(u, h, tokbase, n0)
        const int qn = n0 + 16 * wid + fr; const size_t qtok = (size_t)(tokbase + qn * DIL);
        bf16_t* qp = Z + qtok * Z0W + 1536 + 64 * h;
        const bf16x8 Q0 = Qn0, Q1 = Qn1;
        float m_old = -1e30f, l_old = 0.f;
        f32x4 o[4];
        if (!FIRST) {
            m_old = mln[0]; l_old = mln[1];
#pragma unroll
            for (int dt = 0; dt < 4; ++dt) o[dt] = on[dt];
        } else {
#pragma unroll
            for (int dt = 0; dt < 4; ++dt) o[dt] = (f32x4){0.f, 0.f, 0.f, 0.f};
        }
        if (hn) { ATT_DECODE(un, h1, tb1, n01) ATT_LOAD(h1, tb1, n01); ATT_LOADQ(h1, tb1, n01); }
        f32x4 st[9];
#pragma unroll
        for (int jt = 0; jt < 9; ++jt) {
            const LAS unsigned char* kp = Ks + (16 * wid + 16 * jt + fr) * APITCH + 16 * fq;
            const bf16x8 k0 = *(const LAS bf16x8*)kp, k1 = *(const LAS bf16x8*)(kp + 64);
            f32x4 s = {0.f, 0.f, 0.f, 0.f};
            s = __builtin_amdgcn_mfma_f32_16x16x32_bf16(k0, Q0, s, 0, 0, 0);
            s = __builtin_amdgcn_mfma_f32_16x16x32_bf16(k1, Q1, s, 0, 0, 0);
            st[jt] = s;
        }
        const float C = 0.18033688011112042f;
        float mx = -1e30f;
        const bool edge = (n0 == 0) || (n0 + 192 > L);
        if (!edge) {
#pragma unroll
            for (int jt = 0; jt < 9; ++jt)
#pragma unroll
                for (int e = 0; e < 4; ++e) {
                    float s = st[jt][e];
                    if (jt == 0) { if (4 * fq + e - fr < 0) s = -__builtin_inff(); }
                    if (jt == 8) { if (4 * fq + e - fr > 0) s = -__builtin_inff(); }
                    st[jt][e] = s; mx = fmaxf(mx, s);
                }
        } else {
#pragma unroll
            for (int jt = 0; jt < 9; ++jt)
#pragma unroll
                for (int e = 0; e < 4; ++e) {
                    const int delta = -64 + 16 * jt + 4 * fq + e - fr, nk = qn + delta;
                    const bool valid = (delta >= -64) && (delta <= 64) && (nk >= 0) && (nk < L);
                    const float s = valid ? st[jt][e] : -__builtin_inff();
                    st[jt][e] = s; mx = fmaxf(mx, s);
                }
        }
        mx = fmaxf(mx, __shfl_xor(mx, 16)); mx = fmaxf(mx, __shfl_xor(mx, 32));
        const float m_new = fmaxf(m_old, mx * C); const float alpha = __builtin_amdgcn_exp2f(m_old - m_new);
        float ls = 0.f;
#pragma unroll
        for (int jt = 0; jt < 9; ++jt)
#pragma unroll
            for (int e = 0; e < 4; ++e) { const float p = __builtin_amdgcn_exp2f(__builtin_fmaf(st[jt][e], C, -m_new)); st[jt][e] = p; ls += p; }
        ls += __shfl_xor(ls, 16); ls += __shfl_xor(ls, 32);
        const float l_new = l_old * alpha + ls;
#pragma unroll
        for (int dt = 0; dt < 4; ++dt) o[dt] = o[dt] * alpha;
#pragma unroll
        for (int kk = 0; kk < 5; ++kk) {
            union { unsigned w[4]; bf16x8 v; } pf;
            pf.w[0] = cvt_pk_bf16(st[2 * kk][0], st[2 * kk][1]); pf.w[1] = cvt_pk_bf16(st[2 * kk][2], st[2 * kk][3]);
            if (kk < 4) { pf.w[2] = cvt_pk_bf16(st[2 * kk + 1][0], st[2 * kk + 1][1]); pf.w[3] = cvt_pk_bf16(st[2 * kk + 1][2], st[2 * kk + 1][3]); } else { pf.w[2] = 0u; pf.w[3] = 0u; }
            const LAS unsigned char* vp = Vs + (16 * wid + 32 * kk + 4 * fq + (fr >> 2)) * APITCH + 8 * (fr & 3);
            s16x4 tv[4][2];
#pragma unroll
            for (int dt = 0; dt < 4; ++dt) { tv[dt][0] = vtr(vp + 32 * dt); tv[dt][1] = vtr(vp + 32 * dt + 16 * APITCH); }
#pragma unroll
            for (int dt = 0; dt < 4; ++dt) {
                union { s16x4 h[2]; bf16x8 v; } af;
                af.h[0] = tv[dt][0]; af.h[1] = tv[dt][1];
                o[dt] = __builtin_amdgcn_mfma_f32_16x16x32_bf16(af.v, pf.v, o[dt], 0, 0, 0);
            }
        }
        if (LAST) {
            const float inv = 1.0f / l_new;
#pragma unroll
            for (int dt = 0; dt < 4; ++dt) { u32x2 w; w.x = cvt_pk_bf16(o[dt][0] * inv, o[dt][1] * inv); w.y = cvt_pk_bf16(o[dt][2] * inv, o[dt][3] * inv);
                *(u32x2*)(qp + 16 * dt + 4 * fq) = w; }
        } else {
#pragma unroll
            for (int dt = 0; dt < 4; ++dt) *(f32x4*)(OACC + qtok * 512 + 64 * h + 16 * dt + 4 * fq) = o[dt];
            if (fq == 0) *(f32x2*)(ML + qtok * 16 + 2 * h) = (f32x2){m_new, l_new};
        }
}

template <int DIL, bool FIRST, bool LAST>
__device__ __forceinline__ void attn_phase(LAS unsigned char* lds, bf16_t* Z, const bf16_t* KH, const bf16_t* VH, float* OACC, float* ML, int tid) {
    constexpr int NU = 3072;
    LAS unsigned char* Ks = lds; LAS unsigned char* Vs = lds + AROWS * APITCH;
    const int wid = __builtin_amdgcn_readfirstlane(tid >> 6), lane = tid & 63, fr = lane & 15, fq = lane >> 4;
    for (int i = tid; i < 16 * APITCH / 4; i += NTHREADS) ((LAS unsigned*)(Vs + 256 * APITCH))[i] = 0u;
    const int srow = tid >> 3, sch = tid & 7;
    u32x4 kA[4], vA[4], kB[4], vB[4]; bf16x8 QA0, QA1, QB0, QB1; f32x4 oA[4], oB[4]; f32x2 mA = {-1e30f, 0.f}, mB = {-1e30f, 0.f};
    const int G = gridDim.x; int u = blockIdx.x;
    if (u < NU) attn_prefetch<DIL, FIRST>(Z, KH, VH, OACC, ML, wid, fr, fq, srow, sch, kA, vA, QA0, QA1, oA, mA, u);
    if (u + G < NU) attn_prefetch<DIL, FIRST>(Z, KH, VH, OACC, ML, wid, fr, fq, srow, sch, kB, vB, QB0, QB1, oB, mB, u + G);
    for (; u < NU; u += 2 * G) {
        attn_unit<DIL, FIRST, LAST>(Ks, Vs, Z, KH, VH, OACC, ML, wid, fr, fq, srow, sch, kA, vA, QA0, QA1, oA, mA, u, u + 2 * G, u + 2 * G < NU);
        if (u + G < NU) attn_unit<DIL, FIRST, LAST>(Ks, Vs, Z, KH, VH, OACC, ML, wid, fr, fq, srow, sch, kB, vB, QB0, QB1, oB, mB, u + G, u + 3 * G, u + 3 * G < NU);
    }
    __syncthreads();
}
#undef ATT_DECODE
#undef ATT_LOAD
#undef ATT_LOADQ
#undef ATT_REGS

#define XB_TMO      128
#define XB_XCNT(j)  (256  + 64 * (j))
#define XB_XSUB(j)  (1280 + 64 * (j))
#define XB_XGEN(j)  (2304 + 64 * (j))
#define XB_TOP      3328
#define XB_TOPGEN   3392
#define XCD_BAR_WORDS 3456
#define XB_SPIN_CAP (1u << 18)

__device__ __forceinline__ unsigned xb_ld(unsigned* p)              { return __hip_atomic_load(p, __ATOMIC_RELAXED, __HIP_MEMORY_SCOPE_AGENT); }
__device__ __forceinline__ unsigned xb_add(unsigned* p, unsigned v) { return __hip_atomic_fetch_add(p, v, __ATOMIC_RELAXED, __HIP_MEMORY_SCOPE_AGENT); }
__device__ __forceinline__ unsigned xb_xcc_id() { return (unsigned)__builtin_amdgcn_s_getreg((3 << 11) | 20) & 0xFu; }
#define XB_SPIN(cond, bar) do { unsigned _sp = 0; while (cond) { __builtin_amdgcn_s_sleep(1); \
    if ((++_sp & 255u) == 0u) { if (xb_ld(&(bar)[XB_TMO])) break; if (_sp > XB_SPIN_CAP) { atomicAdd(&(bar)[XB_TMO], 1u); break; } } } } while (0)

struct XcdBarrier {
    unsigned* bar; unsigned x;
    volatile LAS unsigned* st;
};

__device__ __forceinline__ XcdBarrier xcd_barrier_post(unsigned* bar, volatile LAS unsigned* st) {
    XcdBarrier b; b.bar = bar; b.x = xb_xcc_id(); b.st = st;
    if (threadIdx.x == 0) (void)xb_add(&bar[XB_XCNT(b.x)], 1u);
    return b;
}
__device__ __forceinline__ void xcd_barrier_complete(unsigned* bar, unsigned x, unsigned& nloc, unsigned& nx) {
    const unsigned G = gridDim.x * gridDim.y * gridDim.z;
    unsigned sum, cnt, mine, sp = 0u;
    for (;;) {
        sum = 0u; cnt = 0u; mine = 0u;
#pragma unroll
        for (unsigned j = 0; j < 16; ++j) { const unsigned c = xb_ld(&bar[XB_XCNT(j)]); sum += c; cnt += (c > 0u) ? 1u : 0u; mine = (j == x) ? c : mine; }
        if (sum == G) break;
        __builtin_amdgcn_s_sleep(1);
        if ((++sp & 255u) == 0u) { if (xb_ld(&bar[XB_TMO])) break; if (sp > XB_SPIN_CAP) { atomicAdd(&bar[XB_TMO], 1u); break; } }
    }
    nloc = mine > 0u ? mine : 1u; nx = cnt > 0u ? cnt : 1u;
}

__device__ __forceinline__ void xcd_barrier(const XcdBarrier& b) {
    asm volatile("s_waitcnt vmcnt(0)" ::: "memory");
    __syncthreads();
    if (threadIdx.x == 0) {
        unsigned* bar = b.bar;
        __builtin_amdgcn_s_waitcnt(0);
        unsigned nloc = b.st[0], nx = b.st[1];
        if (nloc == 0u) { xcd_barrier_complete(bar, b.x, nloc, nx); b.st[0] = nloc; b.st[1] = nx; }
        const unsigned old = xb_add(&bar[XB_XSUB(b.x)], 1u);
        const unsigned gen = old / nloc;
        if (old + 1u == (gen + 1u) * nloc) {
            __builtin_amdgcn_fence(__ATOMIC_RELEASE, "agent");
            asm volatile("s_waitcnt vmcnt(0)" ::: "memory");
            const unsigned og = xb_add(&bar[XB_TOP], 1u);
            const unsigned tg = og / nx;
            if (og + 1u == (tg + 1u) * nx) xb_add(&bar[XB_TOPGEN], 1u);
            else XB_SPIN(xb_ld(&bar[XB_TOPGEN]) == tg, bar);
            __builtin_amdgcn_fence(__ATOMIC_ACQUIRE, "agent");
            xb_add(&bar[XB_XGEN(b.x)], 1u);
            asm volatile("s_waitcnt vmcnt(0)" ::: "memory");
        } else {
            XB_SPIN(xb_ld(&bar[XB_XGEN(b.x)]) == gen, bar);
            __builtin_amdgcn_fence(__ATOMIC_ACQUIRE, "agent");
            asm volatile("s_waitcnt vmcnt(0)" ::: "memory");
        }
    }
    __syncthreads();
}

__device__ __forceinline__ void build_rstd_table(const pg8::StaticOrder& S, const float* SSQ, LAS unsigned char* lds, int tid) {
    LAS int* PML = (LAS int*)(lds + RING_BYTES + 512); LAS float* RT = (LAS float*)(lds + RING_BYTES + 1024);
    if (tid == 0) {
        int n = 0; pg8::Unit u;
        for (int i = 0; S.next(i, u); ++i) { bool f = false; for (int k = 0; k < n; ++k) f = f || (PML[k] == u.pm); if (!f && n < 8) PML[n++] = u.pm; }
        for (int k = n; k < 8; ++k) PML[k] = -1;
    }
    __syncthreads();
    for (int idx = tid; idx < 8 * 256; idx += NTHREADS) { const int pm = PML[idx >> 8]; if (pm >= 0) RT[idx] = pg8::row_rstd(SSQ, pm * 256 + (idx & 255)); }
    __syncthreads();
}

constexpr int NPHASES = 21;
__global__ void __launch_bounds__(NTHREADS, 2) trunk_fwd(Args args) {
    extern __shared__ __attribute__((aligned(16))) unsigned char lds_raw[];
    LAS unsigned char* lds = (LAS unsigned char*)lds_raw;
    const int tid = threadIdx.x, wave = __builtin_amdgcn_readfirstlane(tid >> 6);
#define lane (tid & 63)
    const int G = gridDim.x, bx = blockIdx.x;
#define gw (bx * NWAVES + wave)
#define ngw (G * NWAVES)
#define gtid (bx * NTHREADS + tid)
#define nthr (G * NTHREADS)
    unsigned char* ws = args.ws;
    float* X = args.out; bf16_t* XB = (bf16_t*)(ws + WS_XB); float* SSQ = (float*)(ws + WS_SSQ);
    bf16_t* BIG = (bf16_t*)(ws + WS_BIG);
    const int lo = args.ph_lo, hi = args.ph_hi;
    unsigned* barw = (unsigned*)ws;
    if (lo == 0) { if (bx == 0) for (int i = tid; i < XCD_BAR_WORDS; i += NTHREADS) barw[i] = 0u; }
    if (tid < 16) ((LAS unsigned*)(lds + RING_BYTES))[tid + 16] = 0u;
    __syncthreads();
    XcdBarrier bar; bar.bar = barw; bar.x = 0; bar.st = (volatile LAS unsigned*)(lds + RING_BYTES + 64);
#ifndef PH_MASK
#define PH_MASK 0x1fffff
#endif
#define IN(k) (((PH_MASK >> (k)) & 1) && lo <= (k) && (k) < hi)
#define GSYNC() xcd_barrier(bar)
#define SEAM(k) do { if (IN(k) && IN((k) + 1)) { if ((k) == 0) { cg::this_grid().sync(); bar = xcd_barrier_post(barw, (volatile LAS unsigned*)(lds + RING_BYTES + 64)); } else { GSYNC(); } } } while (0)
#define RT_PTR ((const LAS float*)(lds + RING_BYTES + 1024))
#define PML_PTR ((const LAS int*)(lds + RING_BYTES + 512))
#define GEMM_PHASE_RS(EPI, g_, e_) do { pg8::StaticOrder S_; S_.init((g_).M, (g_).N, G, bx); build_rstd_table(S_, SSQ, lds, tid); pg8::gemm_phase<EPI, pg8::StaticOrder, true, true>(lds, g_, S_, e_); } while (0)
#define GEMM_PHASE(EPI, g_, e_) do { pg8::StaticOrder S_; S_.init((g_).M, (g_).N, G, bx); pg8::gemm_phase<EPI, pg8::StaticOrder, true, true>(lds, g_, S_, e_); } while (0)

#ifndef REP_MASK
#define REP_MASK 0
#endif
#define RUNPH(k, DRY, REAL) if (IN(k)) { if ((REP_MASK >> (k)) & 1) { DRY; if ((k) == 0) cg::this_grid().sync(); else GSYNC(); } REAL; } SEAM(k);
    RUNPH(0, prologue(args, lds, gw, ngw, wave, lane), prologue(args, lds, gw, ngw, wave, lane))
#define FFN_UP_BODY(f) { pg8::Gemm g{XB, (const bf16_t*)(ws + WS_W + (f) * WS_FFN_STRIDE + WS_W1T_OFF), T_TOK, 2 * DFF, DM, DM, 30, 0}; \
        pg8::EpiGateUp E{BIG, SSQ, RT_PTR, PML_PTR}; GEMM_PHASE_RS(pg8::EpiGateUp, g, E); }
#define FFN_DOWN_BODY(f, sc) { pg8::Gemm g{BIG, (const bf16_t*)(ws + WS_W + (f) * WS_FFN_STRIDE + WS_W2T_OFF), T_TOK, DM, DFF, DFF, 30, 0}; \
        pg8::EpiResid E{XB, SSQ, sc, nullptr, nullptr}; GEMM_PHASE(pg8::EpiResid, g, E); }
#define LATE_CONVERT(lo1, hi1, lo2, hi2) if (bx >= G / 2) { const int w_ = (bx - G / 2) * NWAVES + wave, nw_ = (G - G / 2) * NWAVES; \
        convert_items(args, lds, lo1, hi1, w_, nw_, wave, lane); convert_items(args, lds, lo2, hi2, w_, nw_, wave, lane); }
#define FFN_UP(k, f) RUNPH(k, FFN_UP_BODY(f), FFN_UP_BODY(f))
#define FFN_DOWN(k, f) RUNPH(k, FFN_DOWN_BODY(f, 0.0f), FFN_DOWN_BODY(f, 0.5f))
#define FFN_DOWN0_BODY(sc) { pg8::Gemm g{BIG, (const bf16_t*)(ws + WS_W + WS_W2T_OFF), T_TOK, DM, DFF, DFF, 30, 0}; \
        pg8::EpiResidIn E{XB, SSQ, sc, args.in[0], args.in[1]}; GEMM_PHASE(pg8::EpiResidIn, g, E); }
    RUNPH(1, FFN_UP_BODY(0), { FFN_UP_BODY(0) LATE_CONVERT(4224, 8448, 16896, 18944) })
    RUNPH(2, FFN_DOWN0_BODY(0.0f), FFN_DOWN0_BODY(0.5f))
    bf16_t* AKH = (bf16_t*)X + (size_t)T_TOK * DM; bf16_t* AVH = AKH + (size_t)T_TOK * 512;
#define WIN0_BODY { pg8::Gemm g{XB, (const bf16_t*)(ws + WS_L0WIN), T_TOK, Z0W, DM, DM, 30, 0}; pg8::EpiZ0 E{BIG, SSQ, RT_PTR, PML_PTR, (const float*)(ws + WS_ROPE), AKH, AVH}; GEMM_PHASE_RS(pg8::EpiZ0, g, E); }
    RUNPH(3, WIN0_BODY, WIN0_BODY)
#define ATT1_BODY attn_phase<1, true, false>(lds, BIG, AKH, AVH, X, (float*)(ws + WS_ML), tid);
    RUNPH(4, ATT1_BODY, { conv_gate0(BIG, args.in[8], gtid, nthr); ATT1_BODY })
    if (IN(5)) attn_phase<4, false, false>(lds, BIG, AKH, AVH, X, (float*)(ws + WS_ML), tid);
    SEAM(5);
    if (IN(6)) attn_phase<16, false, true>(lds, BIG, AKH, AVH, X, (float*)(ws + WS_ML), tid);
    SEAM(6);
#define WOUT0_BODY(sc) { pg8::Gemm g{BIG + 1024, (const bf16_t*)(ws + WS_L0WOUT), T_TOK, DM, DM, Z0W, 30, 0}; pg8::EpiResid E{XB, SSQ, sc, nullptr, nullptr}; GEMM_PHASE(pg8::EpiResid, g, E); }
    RUNPH(7, WOUT0_BODY(0.0f), WOUT0_BODY(1.0f))
    RUNPH(8, FFN_UP_BODY(1), { FFN_UP_BODY(1) LATE_CONVERT(8448, 12672, 18944, 20992) }) FFN_DOWN(9, 1)
    RUNPH(10, FFN_UP_BODY(2), { FFN_UP_BODY(2) LATE_CONVERT(12672, 16896, 0, 0) }) FFN_DOWN(11, 2)
    bf16_t* XP = BIG; bf16_t* GG = BIG + (size_t)T_TOK * DM; bf16_t* XBC = BIG + 2 * (size_t)T_TOK * DM; bf16_t* Y1 = XP;
#define WIN1_BODY { pg8::Gemm g{XB, (const bf16_t*)(ws + WS_L1WIN), T_TOK, 2048, DM, DM, 30, 0}; pg8::EpiZ1 E{XP, GG, SSQ, RT_PTR, PML_PTR}; GEMM_PHASE_RS(pg8::EpiZ1, g, E); }
    RUNPH(12, WIN1_BODY, WIN1_BODY)
#define CONV1_BODY conv1(XP, XBC, args.in[20], args.in[21], gtid, nthr);
    RUNPH(13, CONV1_BODY, CONV1_BODY)
    bf16_t* LPF = XP; bf16_t* LPB = (bf16_t*)X; bf16_t* LSS = (bf16_t*)X + (size_t)T_TOK * DM;
    float* LCS = (float*)(ws + WS_W); float* LH0 = (float*)(ws + WS_W + 17 * MiB);
#define LRU_BODY { pg8::Gemm g{XBC, (const bf16_t*)(ws + WS_GATES), T_TOK, 4096, 256, DM, 2, 512}; \
        pg8::EpiLru E{XBC, LPF, LPB, LSS, LCS, args.in[23], args.in[25], args.in[26], args.in[28], args.in[30], args.in[31]}; GEMM_PHASE(pg8::EpiLru, g, E); }
    RUNPH(14, LRU_BODY, LRU_BODY)
#define CARRY_BODY lru_carry(LCS, LH0, lds, tid);
    RUNPH(15, CARRY_BODY, CARRY_BODY)
    if (IN(16)) lru_apply(LPF, LPB, LSS, GG, LH0, gtid, nthr);
    SEAM(16);
    Y1 = LSS;
#define WOUT1_BODY(sc) { pg8::Gemm g{Y1, (const bf16_t*)(ws + WS_L1WOUT), T_TOK, DM, DM, DM, 30, 0}; pg8::EpiResid E{XB, SSQ, sc, nullptr, nullptr}; GEMM_PHASE(pg8::EpiResid, g, E); }
    RUNPH(17, WOUT1_BODY(0.0f), WOUT1_BODY(1.0f))
    FFN_UP(18, 3) FFN_DOWN(19, 3)
    if (IN(20)) final_norm(XB, X, args.in[37], gw, ngw, lane);
#undef lane
#undef gw
#undef ngw
#undef gtid
#undef nthr
#undef IN
#undef SEAM
}

extern "C" void kernel_launch(void* const* d_in, const int* in_sizes, int n_in, void* d_out, int out_size, void* d_ws, size_t ws_size, hipStream_t stream) {
    static int grid = 0;
    if (grid == 0) {
        if (n_in != 38 || out_size != T_TOK * DM || ws_size < WS_END) { fprintf(stderr, "kernel_launch: unexpected shapes (n_in %d, out %d, ws %zu); nothing launched\n", n_in, out_size, ws_size); grid = -1; return; }
        int dev = 0, cus = 0, per_cu = 0;
        if (hipGetDevice(&dev) != hipSuccess || hipDeviceGetAttribute(&cus, hipDeviceAttributeMultiprocessorCount, dev) != hipSuccess) { grid = -1; return; }
        if (hipFuncSetAttribute((const void*)trunk_fwd, hipFuncAttributeMaxDynamicSharedMemorySize, LDS_BYTES) != hipSuccess) { fprintf(stderr, "kernel_launch: hipFuncSetAttribute failed\n"); grid = -1; return; }
        if (hipOccupancyMaxActiveBlocksPerMultiprocessor(&per_cu, (const void*)trunk_fwd, NTHREADS, LDS_BYTES) != hipSuccess || per_cu < 1) { fprintf(stderr, "kernel_launch: occupancy query says %d\n", per_cu); per_cu = 1; }
        (void)hipGetLastError();
        grid = cus * per_cu;
    }
    if (grid < 0) return;
    Args a{};
    for (int i = 0; i < 38; ++i) a.in[i] = (const float*)d_in[i];
    a.out = (float*)d_out; a.ws = (unsigned char*)d_ws;
#if MK_N_LAUNCHES == 1
    a.ph_lo = 0; a.ph_hi = NPHASES;
    void* kargs[] = {&a};
    hipError_t e = hipLaunchCooperativeKernel((const void*)trunk_fwd, dim3(grid), dim3(NTHREADS), kargs, LDS_BYTES, stream);
    if (e != hipSuccess) fprintf(stderr, "cooperative launch failed: %s (grid %d)\n", hipGetErrorString(e), grid);
#else
    for (int k = 0; k < NPHASES; ++k) {
        a.ph_lo = k; a.ph_hi = k + 1;
        hipLaunchKernelGGL(trunk_fwd, dim3(grid), dim3(NTHREADS), LDS_BYTES, stream, a);
    }
#endif
}
```

```cpp
#include <hip/hip_runtime.h>
#include <hip/hip_cooperative_groups.h>
#include <cstdio>
#include <cstdint>
namespace cg = cooperative_groups;

#ifndef MK_N_LAUNCHES
#define MK_N_LAUNCHES 1
#endif

constexpr int T_TOK = 49152, SEQ = 16384, DM = 1024, DFF = 2816, Z0W = 3072;
constexpr float EPS = 1e-6f;

constexpr size_t MiB = 1u << 20;
constexpr size_t WS_ROPE = 1 * MiB;
constexpr size_t WS_SSQ = 2 * MiB;
constexpr size_t WS_LRC = 5 * MiB;
constexpr size_t WS_W = 6 * MiB;
constexpr size_t WS_FFN_STRIDE = 17 * MiB;
constexpr size_t WS_W1T_OFF = 0, WS_W2T_OFF = 11 * MiB;
constexpr size_t WS_L0WIN = 74 * MiB, WS_L0WOUT = 80 * MiB, WS_L1WIN = 82 * MiB, WS_L1WOUT = 86 * MiB, WS_GATES = 88 * MiB;
constexpr size_t WS_XB = 92 * MiB;
constexpr size_t WS_ML = 188 * MiB;
constexpr size_t WS_BIG = 192 * MiB;
constexpr size_t WS_END = 480 * MiB;

namespace pg8 {
#define PG8_LAS __attribute__((address_space(3)))
typedef unsigned short bf16_t;
typedef short bf16x8 __attribute__((ext_vector_type(8)));
typedef float f32x4 __attribute__((ext_vector_type(4)));
typedef unsigned u32x4 __attribute__((ext_vector_type(4)));
constexpr int BM = 256, BK = 64, HALF = 128, HTB = HALF * BK * 2  , STAGE_BYTES = 8 * HTB, NXCD = 8, WGM = 8;

__host__ __device__ __forceinline__ int lds_byte(int r, int c) { const int st = (r >> 4) * 2 + (c >> 5), rr = r & 15, cc = c & 31, ob = rr * 64 + cc * 2; return st * 1024 + (ob ^ (((ob >> 9) & 1) << 5)); }
__host__ __device__ __forceinline__ void stage_rc(int b, int& R, int& C) { const int st = b / 1024, sb = b % 1024, swz = sb ^ (((sb >> 9) & 1) << 5); R = (st >> 1) * 16 + swz / 64; C = (st & 1) * 32 + (swz % 64) / 2; }
__host__ __device__ __forceinline__ int perm32(int rho) { const int n = rho >> 4, i = rho & 15; return 8 * (i >> 2) + 4 * n + (i & 3); }

struct Unit { int pm, pn; };
struct Gemm { const bf16_t* A; const bf16_t* Bt; int M, N, K, lda, ash, astride; };

struct StaticOrder {
    int nM, nN, nwg, G, c;
    __host__ __device__ void init(int M, int N, int G_, int c_) { nM = M / BM; nN = N / BM; nwg = nM * nN; G = G_; c = c_; }
    __host__ __device__ bool next(int i, Unit& u) const {
        const long L = (long)i * G + c; if (L >= nwg) return false;
        int wgid = (int)L; { const int q = nwg / NXCD, r = nwg % NXCD, xcd = wgid % NXCD, off = wgid / NXCD; wgid = (xcd < r ? xcd * (q + 1) : r * (q + 1) + (xcd - r) * q) + off; }
        const int nig = WGM * nN, gid = wgid / nig, fm = gid * WGM, gsz = (nM - fm) < WGM ? (nM - fm) : WGM;
        u.pm = fm + ((wgid % nig) % gsz); u.pn = (wgid % nig) / gsz; return true;
    }
    __device__ __forceinline__ void a_ready(const Unit&) const {}
    __device__ __forceinline__ void done(const Unit&) const {}
};

__device__ __forceinline__ unsigned cvt_pk_bf16(float lo, float hi) { unsigned r; asm("v_cvt_pk_bf16_f32 %0, %1, %2" : "=v"(r) : "v"(lo), "v"(hi)); return r; }

typedef float f32x2 __attribute__((ext_vector_type(2)));
typedef unsigned u32x2 __attribute__((ext_vector_type(2)));
__device__ __forceinline__ float bf2f(unsigned short b) { return __uint_as_float((unsigned)b << 16); }
__device__ __forceinline__ float bflo(unsigned w) { return __uint_as_float(w << 16); }
__device__ __forceinline__ float bfhi(unsigned w) { return __uint_as_float(w & 0xffff0000u); }
__device__ __forceinline__ float row_rstd(const float* SSQ, int row) {
    const f32x4* p = (const f32x4*)(SSQ + (size_t)row * 16);
    const f32x4 a = p[0], b = p[1], c = p[2], d = p[3];
    const float s = ((a[0] + a[1]) + (a[2] + a[3])) + ((b[0] + b[1]) + (b[2] + b[3])) + ((c[0] + c[1]) + (c[2] + c[3])) + ((d[0] + d[1]) + (d[2] + d[3]));
    return __builtin_amdgcn_rsqf(s * (1.0f / 1024.0f) + 1e-6f);
}
__device__ __forceinline__ float fast_sigmoid(float x) { return __builtin_amdgcn_rcpf(1.0f + __builtin_amdgcn_exp2f(-1.4426950408889634f * x)); }
__device__ __forceinline__ float silu_f(float x) { return x * fast_sigmoid(x); }
__device__ __forceinline__ float gelu_tanh_f(float x) { const float in = 0.7978845608028654f * (x + 0.044715f * x * x * x); return x * fast_sigmoid(2.0f * in); }
__device__ __forceinline__ float softplus_neg(float lam) { const float x = __expf(-lam); return (x < 0.03f) ? x * (1.0f - x * (0.5f - x * (0.33333333f - 0.25f * x))) : __logf(1.0f + x); }
template <int CTRL> __device__ __forceinline__ float dppz(float v) {
    return __int_as_float(__builtin_amdgcn_update_dpp(0, __float_as_int(v), CTRL, 0xF, 0xF, true));
}
template <int CTRL> __device__ __forceinline__ float dppf(float old, float v) {
    return __int_as_float(__builtin_amdgcn_update_dpp(__float_as_int(old), __float_as_int(v), CTRL, 0xF, 0xF, false));
}

struct EpiGateUp {
    static constexpr bool PERM = true, AFTER_DRAIN = false, APERM = false;
    bf16_t* H; const float* SSQ; const PG8_LAS float* RT; const PG8_LAS int* PML;
    __device__ __forceinline__ void operator()(f32x4 (&acc)[2][2][4][2], const Unit& u, int wr, int wc, int fr, int fq) const {
        const int row0 = u.pm * BM + wr * 64 + fr; const int col0 = u.pn * 128 + wc * 32 + 8 * fq;
        int slot = -1;
#pragma unroll
        for (int k = 0; k < 8; ++k) slot = (PML[k] == u.pm) ? k : slot;
        float rsv[2][4];
#pragma unroll
        for (int ai = 0; ai < 2; ++ai)
#pragma unroll
            for (int m = 0; m < 4; ++m) rsv[ai][m] = (slot >= 0) ? RT[slot * 256 + ai * HALF + wr * 64 + m * 16 + fr] : row_rstd(SSQ, row0 + ai * HALF + m * 16);
#pragma unroll
        for (int ai = 0; ai < 2; ++ai)
#pragma unroll
            for (int m = 0; m < 4; ++m) {
                const int row = row0 + ai * HALF + m * 16; const float rs = rsv[ai][m]; const float rsl = rs * -1.4426950408889634f, rs2 = rs * rs;
                float h[8];
#pragma unroll
                for (int n = 0; n < 2; ++n)
#pragma unroll
                    for (int e = 0; e < 4; ++e) { const float ag = acc[ai][0][m][n][e], au = acc[ai][1][m][n][e];
                        const float r = __builtin_amdgcn_rcpf(1.0f + __builtin_amdgcn_exp2f(ag * rsl)); h[4 * n + e] = ((ag * au) * rs2) * r; }
                u32x4 w; w.x = cvt_pk_bf16(h[0], h[1]); w.y = cvt_pk_bf16(h[2], h[3]); w.z = cvt_pk_bf16(h[4], h[5]); w.w = cvt_pk_bf16(h[6], h[7]);
                *(u32x4*)(H + (size_t)row * 2816 + col0) = w;
            }
    }
};

template <bool FROM_INPUT> struct EpiResidT {
    static constexpr bool PERM = true, AFTER_DRAIN = false, APERM = false;
    bf16_t* XB; float* SSQ; float scale; const float* X0; const float* X1;
    __device__ __forceinline__ void operator()(f32x4 (&acc)[2][2][4][2], const Unit& u, int wr, int wc, int fr, int fq) const {
        const int row0 = u.pm * BM + wr * 64 + fr; const int col0 = u.pn * BM + wc * 32 + 8 * fq;
#pragma unroll
        for (int ai = 0; ai < 2; ++ai) {
            f32x4 xv[4][2][2];
#pragma unroll
            for (int m = 0; m < 4; ++m) {
                const int row = row0 + ai * HALF + m * 16;
                if (FROM_INPUT) {
                    const float* xs = (row < 16384 ? X0 + (size_t)row * 1024 : X1 + (size_t)(row - 16384) * 1024) + col0;
#pragma unroll
                    for (int bj = 0; bj < 2; ++bj) { xv[m][bj][0] = *(const f32x4*)(xs + bj * HALF); xv[m][bj][1] = *(const f32x4*)(xs + bj * HALF + 4); }
                } else {
#pragma unroll
                    for (int bj = 0; bj < 2; ++bj) { const u32x4 w = *(const u32x4*)(XB + (size_t)row * 1024 + col0 + bj * HALF);
                        xv[m][bj][0] = (f32x4){bflo(w.x), bfhi(w.x), bflo(w.y), bfhi(w.y)}; xv[m][bj][1] = (f32x4){bflo(w.z), bfhi(w.z), bflo(w.w), bfhi(w.w)}; }
                }
            }
#pragma unroll
            for (int m = 0; m < 4; ++m) {
                const int row = row0 + ai * HALF + m * 16; float ss = 0.f;
#pragma unroll
                for (int bj = 0; bj < 2; ++bj) {
                    const f32x4 x0 = xv[m][bj][0] + acc[ai][bj][m][0] * scale, x1 = xv[m][bj][1] + acc[ai][bj][m][1] * scale;
                    ss += (x0[0] * x0[0] + x0[1] * x0[1]) + (x0[2] * x0[2] + x0[3] * x0[3]) + (x1[0] * x1[0] + x1[1] * x1[1]) + (x1[2] * x1[2] + x1[3] * x1[3]);
                    u32x4 w; w.x = cvt_pk_bf16(x0[0], x0[1]); w.y = cvt_pk_bf16(x0[2], x0[3]); w.z = cvt_pk_bf16(x1[0], x1[1]); w.w = cvt_pk_bf16(x1[2], x1[3]);
                    *(u32x4*)(XB + (size_t)row * 1024 + col0 + bj * HALF) = w;
                }
                ss += __shfl_xor(ss, 16); ss += __shfl_xor(ss, 32);
                if (fq == 0) SSQ[(size_t)row * 16 + u.pn * 4 + wc] = ss;
            }
        }
    }
};
typedef EpiResidT<false> EpiResid;
typedef EpiResidT<true> EpiResidIn;

struct EpiZ0 {
    static constexpr bool PERM = true, AFTER_DRAIN = false, APERM = false;
    bf16_t* Z; const float* SSQ; const PG8_LAS float* RT; const PG8_LAS int* PML; const float* ROPE; bf16_t* KH; bf16_t* VH;
    __device__ __forceinline__ void operator()(f32x4 (&acc)[2][2][4][2], const Unit& u, int wr, int wc, int fr, int fq) const {
        const int row0 = u.pm * BM + wr * 64 + fr; const int col0 = u.pn * BM + wc * 32 + 8 * fq;
        const bool rope = (u.pn >= 6) && (u.pn <= 9) && ((wc & 1) == 0);
        int slot = -1;
#pragma unroll
        for (int k = 0; k < 8; ++k) slot = (PML[k] == u.pm) ? k : slot;
        float rsv[2][4];
#pragma unroll
        for (int ai = 0; ai < 2; ++ai)
#pragma unroll
            for (int m = 0; m < 4; ++m) rsv[ai][m] = (slot >= 0) ? RT[slot * 256 + ai * HALF + wr * 64 + m * 16 + fr] : row_rstd(SSQ, row0 + ai * HALF + m * 16);
        f32x4 bc0 = {1.f, 1.f, 1.f, 1.f}, bc1 = bc0, bs0 = {0.f, 0.f, 0.f, 0.f}, bs1 = bs0;
        if (rope) { const f32x4* rp = (const f32x4*)(ROPE + (size_t)(row0 & (SEQ - 1)) * 16); bc0 = rp[0]; bc1 = rp[1]; bs0 = rp[2]; bs1 = rp[3]; }
        const f32x4 C16a = {-9.576594803e-01f, -9.992462593e-01f, 8.243765146e-01f, 9.932003012e-01f}, C16b = {9.997440109e-01f, 9.999903729e-01f, 9.999996380e-01f, 9.999999864e-01f};
        const f32x4 S16a = {-2.879033167e-01f, 3.881898152e-02f, 5.660418378e-01f, 1.164180468e-01f}, S16b = {2.262548617e-02f, 4.387956730e-03f, 8.509272408e-04f, 1.650141653e-04f};
        const f32x4 C128a = {-6.928958219e-01f, 9.521412243e-01f, 1.010104153e-01f, 5.950559312e-01f}, C128b = {9.836606904e-01f, 9.993839261e-01f, 9.999768296e-01f, 9.999991287e-01f};
        const f32x4 S128a = {7.210377105e-01f, -3.056584516e-01f, -9.948853683e-01f, 8.036842905e-01f}, S128b = {1.800323475e-01f, 3.509655735e-02f, 6.807366171e-03f, 1.320112945e-03f};
        f32x4 c0 = bc0, c1 = bc1, s0 = bs0, s1 = bs1;
#pragma unroll
        for (int ai = 0; ai < 2; ++ai)
#pragma unroll
            for (int m = 0; m < 4; ++m) {
                const int row = row0 + ai * HALF + m * 16; const float rs = rsv[ai][m];
                if (rope) {
                    if (m == 0 && ai == 1) { c0 = bc0 * C128a - bs0 * S128a; s0 = bs0 * C128a + bc0 * S128a; c1 = bc1 * C128b - bs1 * S128b; s1 = bs1 * C128b + bc1 * S128b; }
                    else if (m > 0) { const f32x4 t0 = c0 * C16a - s0 * S16a, t1 = c1 * C16b - s1 * S16b; s0 = s0 * C16a + c0 * S16a; s1 = s1 * C16b + c1 * S16b; c0 = t0; c1 = t1; }
                }
#pragma unroll
                for (int bj = 0; bj < 2; ++bj) {
                    f32x4 v0 = acc[ai][bj][m][0] * rs, v1 = acc[ai][bj][m][1] * rs;
                    if (rope) {
                        f32x4 p0, p1;
#pragma unroll
                        for (int e = 0; e < 4; ++e) { p0[e] = __shfl_xor(v0[e], 16); p1[e] = __shfl_xor(v1[e], 16); }
                        const float sg = (fq == 0) ? -1.f : 1.f;
                        if (fq < 2) { v0 = v0 * c0 + p0 * s0 * sg; v1 = v1 * c1 + p1 * s1 * sg; }
                    }
                    u32x4 w; w.x = cvt_pk_bf16(v0[0], v0[1]); w.y = cvt_pk_bf16(v0[2], v0[3]); w.z = cvt_pk_bf16(v1[0], v1[1]); w.w = cvt_pk_bf16(v1[2], v1[3]);
                    if (u.pn >= 8) {
                        const int cc = col0 + bj * HALF - 2048, hd = (cc & 511) >> 6, d0 = cc & 63;
                        bf16_t* dst = (cc < 512 ? KH : VH) + ((size_t)((row >> 14) * 8 + hd) * SEQ + (row & (SEQ - 1))) * 64 + d0;
                        *(u32x4*)dst = w;
                    } else *(u32x4*)(Z + (size_t)row * 3072 + col0 + bj * HALF) = w;
                }
            }
    }
};

struct EpiZ1 {
    static constexpr bool PERM = true, AFTER_DRAIN = false, APERM = false;
    bf16_t* XP; bf16_t* GG; const float* SSQ; const PG8_LAS float* RT; const PG8_LAS int* PML;
    __device__ __forceinline__ void operator()(f32x4 (&acc)[2][2][4][2], const Unit& u, int wr, int wc, int fr, int fq) const {
        const int row0 = u.pm * BM + wr * 64 + fr; const bool gate = u.pn >= 4;
        bf16_t* base = gate ? GG : XP; const int col0 = (u.pn & 3) * BM + wc * 32 + 8 * fq;
        int slot = -1;
#pragma unroll
        for (int k = 0; k < 8; ++k) slot = (PML[k] == u.pm) ? k : slot;
        float rsv[2][4];
#pragma unroll
        for (int ai = 0; ai < 2; ++ai)
#pragma unroll
            for (int m = 0; m < 4; ++m) rsv[ai][m] = (slot >= 0) ? RT[slot * 256 + ai * HALF + wr * 64 + m * 16 + fr] : row_rstd(SSQ, row0 + ai * HALF + m * 16);
#pragma unroll
        for (int ai = 0; ai < 2; ++ai)
#pragma unroll
            for (int m = 0; m < 4; ++m) {
                const int row = row0 + ai * HALF + m * 16; const float rs = rsv[ai][m];
#pragma unroll
                for (int bj = 0; bj < 2; ++bj) {
                    f32x4 v0 = acc[ai][bj][m][0] * rs, v1 = acc[ai][bj][m][1] * rs;
                    if (gate) {
#pragma unroll
                        for (int e = 0; e < 4; ++e) { v0[e] = gelu_tanh_f(v0[e]); v1[e] = gelu_tanh_f(v1[e]); }
                    }
                    u32x4 w; w.x = cvt_pk_bf16(v0[0], v0[1]); w.y = cvt_pk_bf16(v0[2], v0[3]); w.z = cvt_pk_bf16(v1[0], v1[1]); w.w = cvt_pk_bf16(v1[2], v1[3]);
                    *(u32x4*)(base + (size_t)row * 1024 + col0 + bj * HALF) = w;
                }
            }
    }
};

struct EpiLru {
    static constexpr bool PERM = true, AFTER_DRAIN = false, APERM = true;
    const bf16_t* XBC; bf16_t* PF; bf16_t* PB; bf16_t* SS; float* CS;
    const float *ba_f, *bi_f, *lam_f, *ba_b, *bi_b, *lam_b;
    template <int DIR>
    __device__ __forceinline__ void one_dir(f32x4 (&acc)[2][2][4][2], const Unit& u, int wr, int fr, int ch0, const u32x2 (&xin)[2][4], f32x4 ba, f32x4 bi, f32x4 sp) const {
#pragma unroll
        for (int ai = 0; ai < 2; ++ai) {
            __builtin_amdgcn_sched_barrier(0);
            const int rowb = u.pm * BM + ai * HALF + wr * 64; const int chunk = rowb >> 6;
            const unsigned ro = (unsigned)(rowb + 4 * fr) * 1024u + (unsigned)ch0;
#pragma unroll
            for (int m = 0; m < 4; ++m) {
                const u32x2 xv = xin[ai][m];
                const float x[4] = {bflo(xv.x), bfhi(xv.x), bflo(xv.y), bfhi(xv.y)};
#pragma unroll
                for (int e = 0; e < 4; ++e) {
                    const float r = __builtin_amdgcn_rcpf(1.0f + __builtin_amdgcn_exp2f(__builtin_fmaf(acc[ai][DIR][m][0][e], -1.4426950408889634f, ba[e])));
                    const float ig = __builtin_amdgcn_rcpf(1.0f + __builtin_amdgcn_exp2f(__builtin_fmaf(acc[ai][DIR][m][1][e], -1.4426950408889634f, bi[e])));
                    const float av = __builtin_amdgcn_exp2f(r * sp[e]);
                    acc[ai][DIR][m][0][e] = av; acc[ai][DIR][m][1][e] = __builtin_amdgcn_sqrtf(__builtin_fmaf(-av, av, 1.0f)) * ig * x[e];
                }
            }
            __builtin_amdgcn_sched_barrier(0);
#pragma unroll
            for (int mm = 1; mm < 4; ++mm) {
                const int m = DIR ? 3 - mm : mm, mp = DIR ? m + 1 : m - 1;
                acc[ai][DIR][m][1] = acc[ai][DIR][m][0] * acc[ai][DIR][mp][1] + acc[ai][DIR][m][1];
                acc[ai][DIR][m][0] = acc[ai][DIR][m][0] * acc[ai][DIR][mp][0];
            }
            f32x4 IP = acc[ai][DIR][DIR ? 0 : 3][0], IS = acc[ai][DIR][DIR ? 0 : 3][1];
#pragma unroll
            for (int e = 0; e < 4; ++e) {
                float p = IP[e], s = IS[e], pp, sq;
                if (DIR == 0) {
                    pp = dppf<0x111>(1.f, p); sq = dppz<0x111>(s); s = p * sq + s; p = p * pp;
                    pp = dppf<0x112>(1.f, p); sq = dppz<0x112>(s); s = p * sq + s; p = p * pp;
                    pp = dppf<0x114>(1.f, p); sq = dppz<0x114>(s); s = p * sq + s; p = p * pp;
                    pp = dppf<0x118>(1.f, p); sq = dppz<0x118>(s); s = p * sq + s; p = p * pp;
                } else {
                    pp = dppf<0x101>(1.f, p); sq = dppz<0x101>(s); s = p * sq + s; p = p * pp;
                    pp = dppf<0x102>(1.f, p); sq = dppz<0x102>(s); s = p * sq + s; p = p * pp;
                    pp = dppf<0x104>(1.f, p); sq = dppz<0x104>(s); s = p * sq + s; p = p * pp;
                    pp = dppf<0x108>(1.f, p); sq = dppz<0x108>(s); s = p * sq + s; p = p * pp;
                }
                IP[e] = p; IS[e] = s;
            }
            if (fr == (DIR ? 0 : 15)) { float* cs = CS + ((unsigned)chunk * 4096u + (unsigned)(DIR * 2048 + ch0)); *(f32x4*)(cs) = IP; *(f32x4*)(cs + 1024) = IS; }
            f32x4 EP, ES;
#pragma unroll
            for (int e = 0; e < 4; ++e) { EP[e] = DIR ? dppf<0x101>(1.f, IP[e]) : dppf<0x111>(1.f, IP[e]); ES[e] = DIR ? dppz<0x101>(IS[e]) : dppz<0x111>(IS[e]); }
#pragma unroll
            for (int m = 0; m < 4; ++m) {
                const f32x4 pf = acc[ai][DIR][m][0] * EP, sf = acc[ai][DIR][m][0] * ES + acc[ai][DIR][m][1];
                u32x2 w; w.x = cvt_pk_bf16(pf[0], pf[1]); w.y = cvt_pk_bf16(pf[2], pf[3]);
                *(u32x2*)((DIR ? PB : PF) + (ro + 1024u * m)) = w;
                if (DIR == 0) acc[ai][0][m][1] = sf;
                else { const f32x4 ssum = acc[ai][0][m][1] + sf; u32x2 v; v.x = cvt_pk_bf16(ssum[0], ssum[1]); v.y = cvt_pk_bf16(ssum[2], ssum[3]); *(u32x2*)(SS + (ro + 1024u * m)) = v; }
            }
        }
    }
    __device__ __forceinline__ void operator()(f32x4 (&acc)[2][2][4][2], const Unit& u, int wr, int wc, int fr, int fq) const {
        const int g = u.pn >> 2, sub = u.pn & 3;
        const int ch0 = 256 * g + 64 * sub + 16 * wc + 4 * fq;
        u32x2 xin[2][4];
#pragma unroll
        for (int ai = 0; ai < 2; ++ai)
#pragma unroll
            for (int m = 0; m < 4; ++m) xin[ai][m] = *(const u32x2*)(XBC + ((unsigned)(u.pm * BM + ai * HALF + wr * 64 + 4 * fr + m) * 1024u + (unsigned)ch0));
        f32x4 baf = *(const f32x4*)(ba_f + ch0), bif = *(const f32x4*)(bi_f + ch0), spf = *(const f32x4*)(lam_f + ch0);
        f32x4 bab = *(const f32x4*)(ba_b + ch0), bib = *(const f32x4*)(bi_b + ch0), spb = *(const f32x4*)(lam_b + ch0);
        one_dir<0>(acc, u, wr, fr, ch0, xin, baf, bif, spf);
        __builtin_amdgcn_sched_barrier(0);
        one_dir<1>(acc, u, wr, fr, ch0, xin, bab, bib, spb);
    }
};


template <class Epi, class Sched, bool ALIGN_EPI = false, bool SP2 = false>
__device__ __forceinline__ void gemm_phase(PG8_LAS unsigned char* lds, const Gemm g, const Sched& S, const Epi& E) {
    const int tid = threadIdx.x, wid = __builtin_amdgcn_readfirstlane(tid >> 6), lane = tid & 63, wr = wid >> 2, wc = wid & 3, fr = lane & 15, fq = lane >> 4;
    const int K = g.K, nt = K / BK;
    unsigned voffA[2], voffB[2];
#pragma unroll
    for (int i = 0; i < 2; ++i) { int R, C; stage_rc(tid * 16 + i * 8192, R, C); const int Rb = Epi::PERM ? ((R & ~31) + perm32(R & 31)) : R;
        const int Ra = Epi::APERM ? ((R & 64) + 4 * (R & 15) + ((R >> 4) & 3)) : R; voffA[i] = (unsigned)(Ra * g.lda + C) * 2u; voffB[i] = (unsigned)(Rb * K + C) * 2u; }
    const size_t kstep = (size_t)(BK * 2);
    const size_t hstepB = (size_t)HALF * K * 2, hstepA = (size_t)HALF * g.lda * 2;
    const size_t tstepB = 2 * hstepB, tstepA = 2 * hstepA;
    const unsigned ldsw = (unsigned)wid * 1024u;
    const int aoff = lds_byte(wr * 64 + fr, fq * 8), boff = lds_byte(wc * 32 + fr, fq * 8);
#define PG8_SA(b, h) (((b) * 2 + (h)) * HTB)
#define PG8_SB(b, h) ((4 + (b) * 2 + (h)) * HTB)
#define PG8_STAGE(bufoff, gbase, voff) do { _Pragma("unroll") for (int _i = 0; _i < 2; ++_i) \
        __builtin_amdgcn_global_load_lds((const unsigned*)((const char*)(gbase) + (voff)[_i]), (PG8_LAS unsigned*)(lds + (bufoff) + ldsw + _i * 8192), 16, 0, 0); } while (0)
#define PG8_LDA(dst, b, h) do { _Pragma("unroll") for (int m = 0; m < 4; ++m) _Pragma("unroll") for (int k = 0; k < 2; ++k) dst[m][k] = *(const PG8_LAS bf16x8*)(lds + PG8_SA(b, h) + aoff + m * 2048 + k * 1024); } while (0)
#define PG8_LDB(dst, b, h) do { _Pragma("unroll") for (int n = 0; n < 2; ++n) _Pragma("unroll") for (int k = 0; k < 2; ++k) dst[n][k] = *(const PG8_LAS bf16x8*)(lds + PG8_SB(b, h) + boff + n * 2048 + k * 1024); } while (0)
#define PG8_MMA(ai, bj, At, Bt) do { __builtin_amdgcn_s_setprio(1); _Pragma("unroll") for (int m = 0; m < 4; ++m) _Pragma("unroll") for (int n = 0; n < 2; ++n) _Pragma("unroll") for (int k = 0; k < 2; ++k) \
        acc[ai][bj][m][n] = __builtin_amdgcn_mfma_f32_16x16x32_bf16(Bt[n][k], At[m][k], acc[ai][bj][m][n], 0, 0, 0); __builtin_amdgcn_s_setprio(0); } while (0)
#define PG8_WAIT_V(n) asm volatile("s_waitcnt vmcnt(" #n ")" ::: "memory")
#define PG8_WAIT_L(n) asm volatile("s_waitcnt lgkmcnt(" #n ")" ::: "memory")
#define PG8_BAR __builtin_amdgcn_s_barrier()
#define PG8_SCHED __builtin_amdgcn_sched_barrier(0)
    Unit cur, nxt; int ui = 0;
    if (!S.next(0, cur)) return;
    f32x4 acc[2][2][4][2];
#pragma unroll
    for (int a = 0; a < 2; ++a)
#pragma unroll
        for (int b = 0; b < 2; ++b)
#pragma unroll
            for (int m = 0; m < 4; ++m)
#pragma unroll
                for (int n = 0; n < 2; ++n) acc[a][b][m][n] = (f32x4){0.f, 0.f, 0.f, 0.f};
    bf16x8 At[4][2], B0[2][2], B1[2][2];
    const char* cA = (const char*)g.A + (size_t)cur.pm * tstepA + (size_t)(cur.pn >> g.ash) * (size_t)g.astride; const char* cB = (const char*)g.Bt + (size_t)cur.pn * tstepB;
    S.a_ready(cur);
    if constexpr (SP2) {
        PG8_STAGE(PG8_SB(0, 0), cB, voffB); PG8_STAGE(PG8_SB(0, 1), cB + hstepB, voffB); PG8_STAGE(PG8_SA(0, 0), cA, voffA); PG8_STAGE(PG8_SA(0, 1), cA + hstepA, voffA);
        if (wr == 1) PG8_BAR;
        PG8_WAIT_V(2); PG8_BAR;
        PG8_STAGE(PG8_SB(1, 0), cB + kstep, voffB); PG8_STAGE(PG8_SA(1, 0), cA + kstep, voffA); PG8_STAGE(PG8_SB(1, 1), cB + hstepB + kstep, voffB);
        PG8_WAIT_V(6); PG8_BAR;
    } else {
        PG8_STAGE(PG8_SB(0, 0), cB, voffB); PG8_STAGE(PG8_SA(0, 0), cA, voffA); PG8_STAGE(PG8_SB(0, 1), cB + hstepB, voffB); PG8_STAGE(PG8_SA(0, 1), cA + hstepA, voffA);
        if (wr == 1) PG8_BAR;
        PG8_WAIT_V(4); PG8_BAR;
        PG8_STAGE(PG8_SB(1, 0), cB + kstep, voffB); PG8_STAGE(PG8_SA(1, 0), cA + kstep, voffA); PG8_STAGE(PG8_SB(1, 1), cB + hstepB + kstep, voffB);
        PG8_WAIT_V(6); PG8_BAR;
    }
    for (;;) {
        const bool has_next = S.next(ui + 1, nxt);
        const char* nA = has_next ? (const char*)g.A + (size_t)nxt.pm * tstepA + (size_t)(nxt.pn >> g.ash) * (size_t)g.astride : cA; const char* nB = has_next ? (const char*)g.Bt + (size_t)nxt.pn * tstepB : cB;
        _Pragma("nounroll") for (int t = 0; t < nt; t += 2) {
            const bool last = (t == nt - 2);
            const char* a1 = cA + (size_t)(t + 1) * kstep;
            const char* a2 = last ? nA : cA + (size_t)(t + 2) * kstep; const char* b2 = last ? nB : cB + (size_t)(t + 2) * kstep;
            const char* a3 = a2 + kstep; const char* b3 = b2 + kstep;
            if (last && has_next) S.a_ready(nxt);
            if constexpr (SP2) {
            PG8_LDB(B0, 0, 0); PG8_LDB(B1, 0, 1); PG8_SCHED; PG8_LDA(At, 0, 0); PG8_STAGE(PG8_SA(1, 1), a1 + hstepA, voffA);
            PG8_WAIT_V(8); PG8_WAIT_L(0); PG8_BAR; PG8_MMA(0, 0, At, B0); PG8_MMA(0, 1, At, B1); PG8_BAR; PG8_SCHED;
            PG8_LDA(At, 0, 1); PG8_STAGE(PG8_SB(0, 0), b2, voffB); PG8_STAGE(PG8_SB(0, 1), b2 + hstepB, voffB); PG8_STAGE(PG8_SA(0, 0), a2, voffA);
            PG8_WAIT_V(8); PG8_WAIT_L(0); PG8_BAR; PG8_MMA(1, 0, At, B0); PG8_MMA(1, 1, At, B1); PG8_BAR; PG8_SCHED;
            PG8_LDB(B0, 1, 0); PG8_LDB(B1, 1, 1); PG8_SCHED; PG8_LDA(At, 1, 0); PG8_STAGE(PG8_SA(0, 1), a2 + hstepA, voffA);
            PG8_WAIT_V(8); PG8_WAIT_L(0); PG8_BAR; PG8_MMA(0, 0, At, B0); PG8_MMA(0, 1, At, B1); PG8_BAR; PG8_SCHED;
            PG8_LDA(At, 1, 1); PG8_STAGE(PG8_SB(1, 0), b3, voffB); PG8_STAGE(PG8_SB(1, 1), b3 + hstepB, voffB); PG8_STAGE(PG8_SA(1, 0), a3, voffA);
            PG8_WAIT_V(8); PG8_WAIT_L(0); PG8_BAR; PG8_MMA(1, 0, At, B0); PG8_MMA(1, 1, At, B1); PG8_BAR; PG8_SCHED;
            } else {
            PG8_LDB(B0, 0, 0); PG8_SCHED; PG8_LDA(At, 0, 0); PG8_STAGE(PG8_SA(1, 1), a1 + hstepA, voffA);
            PG8_WAIT_L(8); PG8_BAR; PG8_WAIT_L(0); PG8_MMA(0, 0, At, B0); PG8_BAR; PG8_SCHED;
            PG8_LDB(B1, 0, 1); PG8_STAGE(PG8_SB(0, 0), b2, voffB);
            PG8_BAR; PG8_WAIT_L(0); PG8_MMA(0, 1, At, B1); PG8_BAR;
            PG8_LDA(At, 0, 1); PG8_STAGE(PG8_SA(0, 0), a2, voffA);
            PG8_BAR; PG8_WAIT_L(0); PG8_MMA(1, 0, At, B0); PG8_BAR; PG8_SCHED;
            PG8_STAGE(PG8_SB(0, 1), b2 + hstepB, voffB);
            PG8_WAIT_V(6); PG8_BAR; PG8_MMA(1, 1, At, B1); PG8_BAR;
            PG8_LDB(B0, 1, 0); PG8_SCHED; PG8_LDA(At, 1, 0); PG8_STAGE(PG8_SA(0, 1), a2 + hstepA, voffA);
            PG8_WAIT_L(8); PG8_BAR; PG8_WAIT_L(0); PG8_MMA(0, 0, At, B0); PG8_BAR; PG8_SCHED;
            PG8_LDB(B1, 1, 1); PG8_STAGE(PG8_SB(1, 0), b3, voffB);
            PG8_BAR; PG8_WAIT_L(0); PG8_MMA(0, 1, At, B1); PG8_BAR;
            PG8_LDA(At, 1, 1); PG8_STAGE(PG8_SA(1, 0), a3, voffA);
            PG8_BAR; PG8_WAIT_L(0); PG8_MMA(1, 0, At, B0); PG8_BAR; PG8_SCHED;
            PG8_STAGE(PG8_SB(1, 1), b3 + hstepB, voffB);
            PG8_WAIT_V(6); PG8_BAR; PG8_MMA(1, 1, At, B1); PG8_BAR;
            }
        }
        if constexpr (ALIGN_EPI) { if (wr == 0) PG8_BAR; }
        if constexpr (!Epi::AFTER_DRAIN) { E(acc, cur, wr, wc, fr, fq); S.done(cur); }
        if (!has_next) break;
#pragma unroll
        for (int a = 0; a < 2; ++a)
#pragma unroll
            for (int b = 0; b < 2; ++b)
#pragma unroll
                for (int m = 0; m < 4; ++m)
#pragma unroll
                    for (int n = 0; n < 2; ++n) acc[a][b][m][n] = (f32x4){0.f, 0.f, 0.f, 0.f};
        cur = nxt; cA = nA; cB = nB; ++ui;
        if constexpr (ALIGN_EPI) { if (wr == 1) PG8_BAR; }
    }
    PG8_WAIT_V(0);
    if constexpr (!ALIGN_EPI) { if (wr == 0) PG8_BAR; }
    PG8_BAR;
    if constexpr (Epi::AFTER_DRAIN) { E.fused(acc, cur, wr, wc, fr, fq, lds, wid, lane); S.done(cur); }
#undef PG8_SA
#undef PG8_SB
#undef PG8_STAGE
#undef PG8_LDA
#undef PG8_LDB
#undef PG8_MMA
#undef PG8_WAIT_V
#undef PG8_WAIT_L
#undef PG8_BAR
#undef PG8_SCHED
}
}


#define LAS __attribute__((address_space(3)))
using pg8::bf16_t; using pg8::bf16x8; using pg8::f32x4; using pg8::u32x4; using pg8::f32x2; using pg8::u32x2; using pg8::cvt_pk_bf16; using pg8::bflo; using pg8::bfhi;
typedef short s16x4 __attribute__((ext_vector_type(4)));
typedef short v4i16_t __attribute__((ext_vector_type(4)));
constexpr int NTHREADS = 512, NWAVES = 8;
constexpr int RING_BYTES = 131072, LDS_BYTES = 147456;
#define LDS_WAIT() asm volatile("s_waitcnt lgkmcnt(0)" ::: "memory")

__device__ __forceinline__ float wave_sum(float v) {
#pragma unroll
    for (int o = 1; o < 64; o <<= 1) v += __shfl_xor(v, o);
    return v;
}

template <class RowMap>
__device__ __forceinline__ void transpose_item(const float* W, int N, int K, const float* gain, bf16_t* WT, RowMap rm, LAS float* scr, int kb, int nb, int lane) {
    const int k0 = 64 * kb, n0 = 32 * nb;
    float v[32];
#pragma unroll
    for (int i = 0; i < 32; ++i) { const int kk = 2 * i + (lane >> 5); v[i] = W[(size_t)(k0 + kk) * N + n0 + (lane & 31)]; }
    if (gain) {
        float gv[32];
#pragma unroll
        for (int i = 0; i < 32; ++i) gv[i] = gain[k0 + 2 * i + (lane >> 5)];
#pragma unroll
        for (int i = 0; i < 32; ++i) v[i] *= gv[i];
    }
#pragma unroll
    for (int i = 0; i < 32; ++i) { const int kk = 2 * i + (lane >> 5); scr[kk * 33 + (lane & 31)] = v[i]; }
    LDS_WAIT(); asm volatile("" ::: "memory");
    const int c = lane & 7;
#pragma unroll
    for (int j = 0; j < 4; ++j) { const int n = (lane >> 3) + 8 * j; const LAS float* s = scr + (8 * c) * 33 + n;
        u32x4 o; o.x = cvt_pk_bf16(s[0 * 33], s[1 * 33]); o.y = cvt_pk_bf16(s[2 * 33], s[3 * 33]); o.z = cvt_pk_bf16(s[4 * 33], s[5 * 33]); o.w = cvt_pk_bf16(s[6 * 33], s[7 * 33]);
        *(u32x4*)(WT + (size_t)rm(n0 + n) * K + k0 + 8 * c) = o; }
    LDS_WAIT(); asm volatile("" ::: "memory");
}
struct RmId { __device__ __forceinline__ int operator()(int n) const { return n; } };
struct RmGateUp { int off; __device__ __forceinline__ int operator()(int n) const { return 256 * (n >> 7) + (n & 127) + off; } };
struct RmWin0 { __device__ __forceinline__ int operator()(int n) const { return (n >= 512 && n < 1024) ? n + 512 : ((n >= 1024 && n < 1536) ? n - 512 : n); } };
struct RmLruGate { int g, gate; __device__ __forceinline__ int operator()(int n) const {
    return (4 * g + (n >> 6)) * 256 + 128 * (gate >> 1) + 32 * ((n >> 4) & 3) + 8 * ((n >> 2) & 3) + 4 * (gate & 1) + (n & 3); } };

struct Args { const float* in[38]; float* out; unsigned char* ws; int ph_lo, ph_hi; };

__device__ __forceinline__ void convert_items(const Args& a, LAS unsigned char* lds, int it_lo, int it_hi, int w, int nw, int wave, int lane) {
    unsigned char* ws = a.ws;
    LAS float* scr = (LAS float*)(lds + wave * 16384);
    constexpr int I_GU = 16 * 88, I_DN = 44 * 32, I_FFN = 2 * I_GU + I_DN;
    constexpr int I_WIN0 = 16 * 96, I_SQ = 16 * 32, I_WIN1 = 16 * 64, I_GATE = 4 * 8;
    constexpr int NITEMS = 4 * I_FFN + I_WIN0 + I_SQ + I_WIN1 + I_SQ + 16 * I_GATE;
    for (int it = it_lo + w; it < it_hi; it += nw) {
        int r = it;
        if (r < 4 * I_FFN) {
            const int f = r / I_FFN; r -= f * I_FFN;
            const float* nrm = (f == 0) ? a.in[2] : (f == 1) ? a.in[10] : (f == 2) ? a.in[14] : a.in[33];
            const float* wg = (f == 0) ? a.in[3] : (f == 1) ? a.in[11] : (f == 2) ? a.in[15] : a.in[34];
            const float* wu = (f == 0) ? a.in[4] : (f == 1) ? a.in[12] : (f == 2) ? a.in[16] : a.in[35];
            const float* wd = (f == 0) ? a.in[5] : (f == 1) ? a.in[13] : (f == 2) ? a.in[17] : a.in[36];
            bf16_t* W1t = (bf16_t*)(ws + WS_W + f * WS_FFN_STRIDE + WS_W1T_OFF); bf16_t* W2t = (bf16_t*)(ws + WS_W + f * WS_FFN_STRIDE + WS_W2T_OFF);
            if (r < I_GU) { transpose_item(wg, DFF, DM, nrm, W1t, RmGateUp{0}, scr, r / 88, r % 88, lane); continue; } r -= I_GU;
            if (r < I_GU) { transpose_item(wu, DFF, DM, nrm, W1t, RmGateUp{128}, scr, r / 88, r % 88, lane); continue; } r -= I_GU;
            transpose_item(wd, DM, DFF, nullptr, W2t, RmId{}, scr, r / 32, r % 32, lane); continue;
        }
        r -= 4 * I_FFN;
        if (r < I_WIN0) { transpose_item(a.in[7], Z0W, DM, a.in[6], (bf16_t*)(ws + WS_L0WIN), RmWin0{}, scr, r / 96, r % 96, lane); continue; } r -= I_WIN0;
        if (r < I_SQ) { transpose_item(a.in[9], DM, DM, nullptr, (bf16_t*)(ws + WS_L0WOUT), RmId{}, scr, r / 32, r % 32, lane); continue; } r -= I_SQ;
        if (r < I_WIN1) { transpose_item(a.in[19], 2048, DM, a.in[18], (bf16_t*)(ws + WS_L1WIN), RmId{}, scr, r / 64, r % 64, lane); continue; } r -= I_WIN1;
        if (r < I_SQ) { transpose_item(a.in[32], DM, DM, nullptr, (bf16_t*)(ws + WS_L1WOUT), RmId{}, scr, r / 32, r % 32, lane); continue; } r -= I_SQ;
        {
            const int mat = r / I_GATE; r -= mat * I_GATE;
            const int gate = mat >> 2, g = mat & 3;
            const float* src = (gate == 0) ? a.in[22] : (gate == 1) ? a.in[24] : (gate == 2) ? a.in[27] : a.in[29];
            transpose_item(src + (size_t)g * 65536, 256, 256, nullptr, (bf16_t*)(ws + WS_GATES), RmLruGate{g, gate}, scr, r / 8, r % 8, lane);
        }
    }
}

__device__ __forceinline__ void prologue(const Args& a, LAS unsigned char* lds, int gw, int ngw, int wave, int lane) {
    unsigned char* ws = a.ws;
    {
        float* R = (float*)(ws + WS_ROPE);
        for (int idx = gw * 64 + lane; idx < SEQ * 8; idx += ngw * 64) {
            const int pos = idx >> 3, i = idx & 7;
            const double f = (i == 0) ? 1.0 : (i == 1) ? 0.19392274474868576 : (i == 2) ? 0.03760603093086393 : (i == 3) ? 0.007292664737217109 :
                             (i == 4) ? 0.001414213562373095 : (i == 5) ? 0.0002742481756762073 : (i == 6) ? 5.318295896944988e-05 : 1.031338537721246e-05;
            const float ang = (float)pos * (float)f;
            double rev = (double)ang * 0.15915494309189535; rev -= floor(rev);
            const float rv = (float)rev;
            R[pos * 16 + i] = __builtin_amdgcn_cosf(rv); R[pos * 16 + 8 + i] = __builtin_amdgcn_sinf(rv);
        }
    }
    {
        float* C = (float*)(ws + WS_LRC);
        for (int idx = gw * 64 + lane; idx < 6 * 1024; idx += ngw * 64) {
            const int k = idx >> 10, ch = idx & 1023;
            const float* src = (k == 0) ? a.in[23] : (k == 1) ? a.in[25] : (k == 2) ? a.in[26] : (k == 3) ? a.in[28] : (k == 4) ? a.in[30] : a.in[31];
            const float v = src[ch];
            C[idx] = (k == 2 || k == 5) ? (-8.0f * 1.4426950408889634f) * pg8::softplus_neg(v) : -1.4426950408889634f * v;
        }
    }
    convert_items(a, lds, 0, 4224, gw, ngw, wave, lane);
    bf16_t* XB = (bf16_t*)(ws + WS_XB); float* SSQ = (float*)(ws + WS_SSQ);
    for (int row = 2 * gw; row < T_TOK; row += 2 * ngw) {
        f32x4 v[2][4]; float s[2];
#pragma unroll
        for (int q = 0; q < 2; ++q) { const int rw = row + q; const float* src = (rw < SEQ) ? a.in[0] + (size_t)rw * DM : a.in[1] + (size_t)(rw - SEQ) * DM;
            const f32x4* xr = (const f32x4*)src + lane;
#pragma unroll
            for (int j = 0; j < 4; ++j) v[q][j] = xr[64 * j]; }
#pragma unroll
        for (int q = 0; q < 2; ++q) { s[q] = 0.f;
#pragma unroll
            for (int j = 0; j < 4; ++j) s[q] += (v[q][j][0] * v[q][j][0] + v[q][j][1] * v[q][j][1]) + (v[q][j][2] * v[q][j][2] + v[q][j][3] * v[q][j][3]);
            s[q] = wave_sum(s[q]); }
#pragma unroll
        for (int q = 0; q < 2; ++q) { const int rw = row + q; u32x2* bo = (u32x2*)(XB + (size_t)rw * DM) + lane;
#pragma unroll
            for (int j = 0; j < 4; ++j) { u32x2 w; w.x = cvt_pk_bf16(v[q][j][0], v[q][j][1]); w.y = cvt_pk_bf16(v[q][j][2], v[q][j][3]); bo[64 * j] = w; }
            if (lane < 16) SSQ[(size_t)rw * 16 + lane] = (lane == 0) ? s[q] : 0.f; }
    }
}

__device__ __forceinline__ void conv_gate0(bf16_t* Z, const float* cw, int gtid, int nthr) {
    const int c8 = (gtid & 63) * 8;
    f32x4 w[3][2];
#pragma unroll
    for (int j = 0; j < 3; ++j) { w[j][0] = *(const f32x4*)(cw + j * 512 + c8); w[j][1] = *(const f32x4*)(cw + j * 512 + c8 + 4); }
    for (int idx = gtid; idx < T_TOK * 64; idx += nthr) {
        const int row = idx >> 6, pos = row & (SEQ - 1);
        u32x4 uu[3], gc[3];
#pragma unroll
        for (int j = 0; j < 3; ++j) { const int t = pos + j - 1; const int rr = row + ((t < 0) ? 0 : (t >= SEQ) ? 0 : j - 1);
            const bf16_t* zr = Z + (size_t)rr * Z0W; uu[j] = *(const u32x4*)(zr + c8); gc[j] = *(const u32x4*)(zr + 512 + c8); }
        bf16_t* gp = Z + (size_t)row * Z0W + 1024 + c8;
        const u32x4 gb = *(const u32x4*)gp;
        float acc[8] = {0.f, 0.f, 0.f, 0.f, 0.f, 0.f, 0.f, 0.f};
#pragma unroll
        for (int j = 0; j < 3; ++j) {
            const int t = pos + j - 1; const float mk = (t >= 0 && t < SEQ) ? 1.f : 0.f;
            const f32x4 w0 = w[j][0] * mk, w1 = w[j][1] * mk;
            acc[0] += w0[0] * (bflo(uu[j].x) * bflo(gc[j].x)); acc[1] += w0[1] * (bfhi(uu[j].x) * bfhi(gc[j].x));
            acc[2] += w0[2] * (bflo(uu[j].y) * bflo(gc[j].y)); acc[3] += w0[3] * (bfhi(uu[j].y) * bfhi(gc[j].y));
            acc[4] += w1[0] * (bflo(uu[j].z) * bflo(gc[j].z)); acc[5] += w1[1] * (bfhi(uu[j].z) * bfhi(gc[j].z));
            acc[6] += w1[2] * (bflo(uu[j].w) * bflo(gc[j].w)); acc[7] += w1[3] * (bfhi(uu[j].w) * bfhi(gc[j].w));
        }
        u32x4 o;
        o.x = cvt_pk_bf16(bflo(gb.x) * acc[0], bfhi(gb.x) * acc[1]); o.y = cvt_pk_bf16(bflo(gb.y) * acc[2], bfhi(gb.y) * acc[3]);
        o.z = cvt_pk_bf16(bflo(gb.z) * acc[4], bfhi(gb.z) * acc[5]); o.w = cvt_pk_bf16(bflo(gb.w) * acc[6], bfhi(gb.w) * acc[7]);
        *(u32x4*)gp = o;
    }
}

__device__ __forceinline__ void conv1(const bf16_t* XP, bf16_t* XBC, const float* cw, const float* cb, int gtid, int nthr) {
    const int c8 = (gtid & 127) * 8;
    f32x4 w[4][2];
#pragma unroll
    for (int j = 0; j < 4; ++j) { w[j][0] = *(const f32x4*)(cw + j * 1024 + c8); w[j][1] = *(const f32x4*)(cw + j * 1024 + c8 + 4); }
    const f32x4 b0 = *(const f32x4*)(cb + c8), b1 = *(const f32x4*)(cb + c8 + 4);
    for (int idx = gtid; idx < T_TOK * 128; idx += nthr) {
        const int row = idx >> 7, pos = row & (SEQ - 1);
        u32x4 xv[4];
#pragma unroll
        for (int j = 0; j < 4; ++j) { const int t = pos + j - 2; const int rr = row + ((t < 0) ? 0 : (t >= SEQ) ? 0 : j - 2); xv[j] = *(const u32x4*)(XP + (size_t)rr * DM + c8); }
        float acc[8] = {b0[0], b0[1], b0[2], b0[3], b1[0], b1[1], b1[2], b1[3]};
#pragma unroll
        for (int j = 0; j < 4; ++j) {
            const int t = pos + j - 2; const float mk = (t >= 0 && t < SEQ) ? 1.f : 0.f;
            const f32x4 w0 = w[j][0] * mk, w1 = w[j][1] * mk;
            acc[0] += w0[0] * bflo(xv[j].x); acc[1] += w0[1] * bfhi(xv[j].x); acc[2] += w0[2] * bflo(xv[j].y); acc[3] += w0[3] * bfhi(xv[j].y);
            acc[4] += w1[0] * bflo(xv[j].z); acc[5] += w1[1] * bfhi(xv[j].z); acc[6] += w1[2] * bflo(xv[j].w); acc[7] += w1[3] * bfhi(xv[j].w);
        }
        u32x4 o; o.x = cvt_pk_bf16(acc[0], acc[1]); o.y = cvt_pk_bf16(acc[2], acc[3]); o.z = cvt_pk_bf16(acc[4], acc[5]); o.w = cvt_pk_bf16(acc[6], acc[7]);
        *(u32x4*)(XBC + (size_t)row * DM + c8) = o;
    }
}

__device__ __forceinline__ void lru_carry(const float* CS, float* H0, LAS unsigned char* lds, int tid) {
    LAS float* gP = (LAS float*)lds; LAS float* gS = gP + 512;
    const int grp = tid >> 5, c = tid & 31;
    for (int u = blockIdx.x; u < 3 * 2 * 32; u += gridDim.x) {
        const int b = u / 64, dir = (u >> 5) & 1, ch = (u & 31) * 32 + c;
        float P = 1.f, S = 0.f; float pv[16], sv[16];
#pragma unroll
        for (int i = 0; i < 16; ++i) { const int o = grp * 16 + i, chunk = b * 256 + (dir ? 255 - o : o);
            pv[i] = CS[(size_t)chunk * 4096 + (dir * 2) * 1024 + ch]; sv[i] = CS[(size_t)chunk * 4096 + (dir * 2 + 1) * 1024 + ch]; }
#pragma unroll
        for (int i = 0; i < 16; ++i) { S = pv[i] * S + sv[i]; P = pv[i] * P; }
        gP[tid] = P; gS[tid] = S;
        __syncthreads();
        float h = 0.f;
        for (int g2 = 0; g2 < grp; ++g2) h = gP[g2 * 32 + c] * h + gS[g2 * 32 + c];
#pragma unroll
        for (int i = 0; i < 16; ++i) { const int o = grp * 16 + i, chunk = b * 256 + (dir ? 255 - o : o);
            H0[(size_t)chunk * 2048 + dir * 1024 + ch] = h; h = pv[i] * h + sv[i]; }
        __syncthreads();
    }
}

__device__ __forceinline__ void lru_apply(const bf16_t* PF, const bf16_t* PB, bf16_t* SS, const bf16_t* GG, const float* H0, int gtid, int nthr) {
    for (int idx = gtid; idx < T_TOK * 128; idx += nthr) {
        const int row = idx >> 7, c8 = (idx & 127) * 8; const unsigned o = (unsigned)row * 1024u + (unsigned)c8;
        const u32x4 pf = *(const u32x4*)(PF + o), pb = *(const u32x4*)(PB + o), ss = *(const u32x4*)(SS + o), gg = *(const u32x4*)(GG + o);
        const float* h0 = H0 + ((unsigned)(row >> 6) * 2048u + (unsigned)c8);
        const f32x4 f0 = *(const f32x4*)h0, f1 = *(const f32x4*)(h0 + 4), b0 = *(const f32x4*)(h0 + 1024), b1 = *(const f32x4*)(h0 + 1028);
        u32x4 y;
        y.x = cvt_pk_bf16((bflo(ss.x) + bflo(pf.x) * f0[0] + bflo(pb.x) * b0[0]) * bflo(gg.x), (bfhi(ss.x) + bfhi(pf.x) * f0[1] + bfhi(pb.x) * b0[1]) * bfhi(gg.x));
        y.y = cvt_pk_bf16((bflo(ss.y) + bflo(pf.y) * f0[2] + bflo(pb.y) * b0[2]) * bflo(gg.y), (bfhi(ss.y) + bfhi(pf.y) * f0[3] + bfhi(pb.y) * b0[3]) * bfhi(gg.y));
        y.z = cvt_pk_bf16((bflo(ss.z) + bflo(pf.z) * f1[0] + bflo(pb.z) * b1[0]) * bflo(gg.z), (bfhi(ss.z) + bfhi(pf.z) * f1[1] + bfhi(pb.z) * b1[1]) * bfhi(gg.z));
        y.w = cvt_pk_bf16((bflo(ss.w) + bflo(pf.w) * f1[2] + bflo(pb.w) * b1[2]) * bflo(gg.w), (bfhi(ss.w) + bfhi(pf.w) * f1[3] + bfhi(pb.w) * b1[3]) * bfhi(gg.w));
        *(u32x4*)(SS + o) = y;
    }
}

__device__ __forceinline__ void final_norm(const bf16_t* XB, float* OUT, const float* gain, int gw, int ngw, int lane) {
    f32x4 gv[2];
#pragma unroll
    for (int j = 0; j < 2; ++j) gv[j] = ((const f32x4*)gain)[2 * lane + j];
    f32x4 gw2[2];
#pragma unroll
    for (int j = 0; j < 2; ++j) gw2[j] = ((const f32x4*)gain)[128 + 2 * lane + j];
    for (int row = gw; row < T_TOK; row += ngw) {
        const u32x4 w0 = *((const u32x4*)(XB + (size_t)row * DM) + lane), w1 = *((const u32x4*)(XB + (size_t)row * DM + 512) + lane);
        f32x4 v[4] = {{bflo(w0.x), bfhi(w0.x), bflo(w0.y), bfhi(w0.y)}, {bflo(w0.z), bfhi(w0.z), bflo(w0.w), bfhi(w0.w)},
                      {bflo(w1.x), bfhi(w1.x), bflo(w1.y), bfhi(w1.y)}, {bflo(w1.z), bfhi(w1.z), bflo(w1.w), bfhi(w1.w)}};
        float s = 0.f;
#pragma unroll
        for (int j = 0; j < 4; ++j) s += (v[j][0] * v[j][0] + v[j][1] * v[j][1]) + (v[j][2] * v[j][2] + v[j][3] * v[j][3]);
        s = wave_sum(s);
        const float rs = 1.0f / sqrtf(s * (1.0f / 1024.0f) + EPS);
        f32x4* o = (f32x4*)(OUT + (size_t)row * DM);
        o[2 * lane] = v[0] * rs * gv[0]; o[2 * lane + 1] = v[1] * rs * gv[1];
        o[128 + 2 * lane] = v[2] * rs * gw2[0]; o[128 + 2 * lane + 1] = v[3] * rs * gw2[1];
    }
}

constexpr int APITCH = 144, AROWS = 272;
__device__ __forceinline__ s16x4 vtr(const LAS unsigned char* p) { return __builtin_bit_cast(s16x4, __builtin_amdgcn_ds_read_tr16_b64_v4i16((LAS v4i16_t*)p)); }

#define ATT_DECODE(uu, h_, tokbase_, n0_) const int h_ = (uu) & 7; const int j_##h_ = (uu) >> 3; const int b_##h_ = j_##h_ >> 7, blk_##h_ = j_##h_ & 127; \
        const int tokbase_ = b_##h_ * SEQ + blk_##h_ / NBR; const int n0_ = (blk_##h_ % NBR) * 128;
#define ATT_LOAD(h_, tokbase_, n0_) do { _Pragma("unroll") for (int i = 0; i < 4; ++i) { const int n = (n0_) - 64 + srow + 64 * i; \
        if (n >= 0 && n < L) { const int tk_ = (tokbase_) + n * DIL; const size_t o_ = ((size_t)((tk_ >> 14) * 8 + (h_)) * SEQ + (tk_ & (SEQ - 1))) * 64 + 8 * sch; kreg[i] = *(const u32x4*)(KH + o_); vreg[i] = *(const u32x4*)(VH + o_); } \
        else { kreg[i] = (u32x4){0u, 0u, 0u, 0u}; vreg[i] = (u32x4){0u, 0u, 0u, 0u}; } } } while (0)
#define ATT_LOADQ(h_, tokbase_, n0_) do { const size_t qt_ = (size_t)((tokbase_) + ((n0_) + 16 * wid + fr) * DIL); const bf16_t* qp_ = Z + qt_ * Z0W + 1536 + 64 * (h_); \
        Qn0 = *(const bf16x8*)(qp_ + 8 * fq); Qn1 = *(const bf16x8*)(qp_ + 32 + 8 * fq); \
        if (!FIRST) { mln = *(const f32x2*)(ML + qt_ * 16 + 2 * (h_)); _Pragma("unroll") for (int dt = 0; dt < 4; ++dt) on[dt] = *(const f32x4*)(OACC + qt_ * 512 + 64 * (h_) + 16 * dt + 4 * fq); } } while (0)

#define ATT_REGS u32x4 (&kreg)[4], u32x4 (&vreg)[4], bf16x8& Qn0, bf16x8& Qn1, f32x4 (&on)[4], f32x2& mln
template <int DIL, bool FIRST>
__device__ __forceinline__ void attn_prefetch(bf16_t* Z, const bf16_t* KH, const bf16_t* VH, float* OACC, float* ML, int wid, int fr, int fq, int srow, int sch, ATT_REGS, int uu) {
    constexpr int L = SEQ / DIL, NBR = 128 / DIL;
    ATT_DECODE(uu, h0, tb0, n00) ATT_LOAD(h0, tb0, n00); ATT_LOADQ(h0, tb0, n00);
}
template <int DIL, bool FIRST, bool LAST>
__device__ __forceinline__ void attn_unit(LAS unsigned char* Ks, LAS unsigned char* Vs, bf16_t* Z, const bf16_t* KH, const bf16_t* VH, float* OACC, float* ML,
                                          int wid, int fr, int fq, int srow, int sch, ATT_REGS, int u, int un, bool hn) {
    constexpr int L = SEQ / DIL, NBR = 128 / DIL;
        __syncthreads();
#pragma unroll
        for (int i = 0; i < 4; ++i) { *(LAS u32x4*)(Ks + (srow + 64 * i) * APITCH + 16 * sch) = kreg[i]; *(LAS u32x4*)(Vs + (srow + 64 * i) * APITCH + 16 * sch) = vreg[i]; }
        __syncthreads();
        ATT_DECODE(u, h, tokbase, n0)
        const int qn = n0 + 16 * wid + fr; const size_t qtok = (size_t)(tokbase + qn * DIL);
        bf16_t* qp = Z + qtok * Z0W + 1536 + 64 * h;
        const bf16x8 Q0 = Qn0, Q1 = Qn1;
        float m_old = -1e30f, l_old = 0.f;
        f32x4 o[4];
        if (!FIRST) {
            m_old = mln[0]; l_old = mln[1];
#pragma unroll
            for (int dt = 0; dt < 4; ++dt) o[dt] = on[dt];
        } else {
#pragma unroll
            for (int dt = 0; dt < 4; ++dt) o[dt] = (f32x4){0.f, 0.f, 0.f, 0.f};
        }
        if (hn) { ATT_DECODE(un, h1, tb1, n01) ATT_LOAD(h1, tb1, n01); ATT_LOADQ(h1, tb1, n01); }
        f32x4 st[9];
#pragma unroll
        for (int jt = 0; jt < 9; ++jt) {
            const LAS unsigned char* kp = Ks + (16 * wid + 16 * jt + fr) * APITCH + 16 * fq;
            const bf16x8 k0 = *(const LAS bf16x8*)kp, k1 = *(const LAS bf16x8*)(kp + 64);
            f32x4 s = {0.f, 0.f, 0.f, 0.f};
            s = __builtin_amdgcn_mfma_f32_16x16x32_bf16(k0, Q0, s, 0, 0, 0);
            s = __builtin_amdgcn_mfma_f32_16x16x32_bf16(k1, Q1, s, 0, 0, 0);
            st[jt] = s;
        }
        const float C = 0.18033688011112042f;
        float mx = -1e30f;
        const bool edge = (n0 == 0) || (n0 + 192 > L);
        if (!edge) {
#pragma unroll
            for (int jt = 0; jt < 9; ++jt)
#pragma unroll
                for (int e = 0; e < 4; ++e) {
                    float s = st[jt][e] * C;
                    if (jt == 0) { if (4 * fq + e - fr < 0) s = -__builtin_inff(); }
                    if (jt == 8) { if (4 * fq + e - fr > 0) s = -__builtin_inff(); }
                    st[jt][e] = s; mx = fmaxf(mx, s);
                }
        } else {
#pragma unroll
            for (int jt = 0; jt < 9; ++jt)
#pragma unroll
                for (int e = 0; e < 4; ++e) {
                    const int delta = -64 + 16 * jt + 4 * fq + e - fr, nk = qn + delta;
                    const bool valid = (delta >= -64) && (delta <= 64) && (nk >= 0) && (nk < L);
                    const float s = valid ? st[jt][e] * C : -__builtin_inff();
                    st[jt][e] = s; mx = fmaxf(mx, s);
                }
        }
        mx = fmaxf(mx, __shfl_xor(mx, 16)); mx = fmaxf(mx, __shfl_xor(mx, 32));
        const float m_new = fmaxf(m_old, mx); const float alpha = __builtin_amdgcn_exp2f(m_old - m_new);
        float ls = 0.f;
#pragma unroll
        for (int jt = 0; jt < 9; ++jt)
#pragma unroll
            for (int e = 0; e < 4; ++e) { const float p = __builtin_amdgcn_exp2f(st[jt][e] - m_new); st[jt][e] = p; ls += p; }
        ls += __shfl_xor(ls, 16); ls += __shfl_xor(ls, 32);
        const float l_new = l_old * alpha + ls;
#pragma unroll
        for (int dt = 0; dt < 4; ++dt) o[dt] = o[dt] * alpha;
#pragma unroll
        for (int kk = 0; kk < 5; ++kk) {
            union { unsigned w[4]; bf16x8 v; } pf;
            pf.w[0] = cvt_pk_bf16(st[2 * kk][0], st[2 * kk][1]); pf.w[1] = cvt_pk_bf16(st[2 * kk][2], st[2 * kk][3]);
            if (kk < 4) { pf.w[2] = cvt_pk_bf16(st[2 * kk + 1][0], st[2 * kk + 1][1]); pf.w[3] = cvt_pk_bf16(st[2 * kk + 1][2], st[2 * kk + 1][3]); } else { pf.w[2] = 0u; pf.w[3] = 0u; }
            const LAS unsigned char* vp = Vs + (16 * wid + 32 * kk + 4 * fq + (fr >> 2)) * APITCH + 8 * (fr & 3);
            s16x4 tv[4][2];
#pragma unroll
            for (int dt = 0; dt < 4; ++dt) { tv[dt][0] = vtr(vp + 32 * dt); tv[dt][1] = vtr(vp + 32 * dt + 16 * APITCH); }
#pragma unroll
            for (int dt = 0; dt < 4; ++dt) {
                union { s16x4 h[2]; bf16x8 v; } af;
                af.h[0] = tv[dt][0]; af.h[1] = tv[dt][1];
                o[dt] = __builtin_amdgcn_mfma_f32_16x16x32_bf16(af.v, pf.v, o[dt], 0, 0, 0);
            }
        }
        if (LAST) {
            const float inv = 1.0f / l_new;
#pragma unroll
            for (int dt = 0; dt < 4; ++dt) { u32x2 w; w.x = cvt_pk_bf16(o[dt][0] * inv, o[dt][1] * inv); w.y = cvt_pk_bf16(o[dt][2] * inv, o[dt][3] * inv);
                *(u32x2*)(qp + 16 * dt + 4 * fq) = w; }
        } else {
#pragma unroll
            for (int dt = 0; dt < 4; ++dt) *(f32x4*)(OACC + qtok * 512 + 64 * h + 16 * dt + 4 * fq) = o[dt];
            if (fq == 0) *(f32x2*)(ML + qtok * 16 + 2 * h) = (f32x2){m_new, l_new};
        }
}

template <int DIL, bool FIRST, bool LAST>
__device__ __forceinline__ void attn_phase(LAS unsigned char* lds, bf16_t* Z, const bf16_t* KH, const bf16_t* VH, float* OACC, float* ML, int tid) {
    constexpr int NU = 3072;
    LAS unsigned char* Ks = lds; LAS unsigned char* Vs = lds + AROWS * APITCH;
    const int wid = __builtin_amdgcn_readfirstlane(tid >> 6), lane = tid & 63, fr = lane & 15, fq = lane >> 4;
    for (int i = tid; i < 16 * APITCH / 4; i += NTHREADS) ((LAS unsigned*)(Vs + 256 * APITCH))[i] = 0u;
    const int srow = tid >> 3, sch = tid & 7;
    u32x4 kA[4], vA[4], kB[4], vB[4]; bf16x8 QA0, QA1, QB0, QB1; f32x4 oA[4], oB[4]; f32x2 mA = {-1e30f, 0.f}, mB = {-1e30f, 0.f};
    const int G = gridDim.x; int u = blockIdx.x;
    if (u < NU) attn_prefetch<DIL, FIRST>(Z, KH, VH, OACC, ML, wid, fr, fq, srow, sch, kA, vA, QA0, QA1, oA, mA, u);
    if (u + G < NU) attn_prefetch<DIL, FIRST>(Z, KH, VH, OACC, ML, wid, fr, fq, srow, sch, kB, vB, QB0, QB1, oB, mB, u + G);
    for (; u < NU; u += 2 * G) {
        attn_unit<DIL, FIRST, LAST>(Ks, Vs, Z, KH, VH, OACC, ML, wid, fr, fq, srow, sch, kA, vA, QA0, QA1, oA, mA, u, u + 2 * G, u + 2 * G < NU);
        if (u + G < NU) attn_unit<DIL, FIRST, LAST>(Ks, Vs, Z, KH, VH, OACC, ML, wid, fr, fq, srow, sch, kB, vB, QB0, QB1, oB, mB, u + G, u + 3 * G, u + 3 * G < NU);
    }
    __syncthreads();
}
#undef ATT_DECODE
#undef ATT_LOAD
#undef ATT_LOADQ
#undef ATT_REGS

#define XB_TMO      128
#define XB_XCNT(j)  (256  + 64 * (j))
#define XB_XSUB(j)  (1280 + 64 * (j))
#define XB_XGEN(j)  (2304 + 64 * (j))
#define XB_TOP      3328
#define XB_TOPGEN   3392
#define XCD_BAR_WORDS 3456
#define XB_SPIN_CAP (1u << 18)

__device__ __forceinline__ unsigned xb_ld(unsigned* p)              { return __hip_atomic_load(p, __ATOMIC_RELAXED, __HIP_MEMORY_SCOPE_AGENT); }
__device__ __forceinline__ unsigned xb_add(unsigned* p, unsigned v) { return __hip_atomic_fetch_add(p, v, __ATOMIC_RELAXED, __HIP_MEMORY_SCOPE_AGENT); }
__device__ __forceinline__ unsigned xb_xcc_id() { return (unsigned)__builtin_amdgcn_s_getreg((3 << 11) | 20) & 0xFu; }
#define XB_SPIN(cond, bar) do { unsigned _sp = 0; while (cond) { __builtin_amdgcn_s_sleep(1); \
    if ((++_sp & 255u) == 0u) { if (xb_ld(&(bar)[XB_TMO])) break; if (_sp > XB_SPIN_CAP) { atomicAdd(&(bar)[XB_TMO], 1u); break; } } } } while (0)

struct XcdBarrier {
    unsigned* bar; unsigned x;
    volatile LAS unsigned* st;
};

__device__ __forceinline__ XcdBarrier xcd_barrier_post(unsigned* bar, volatile LAS unsigned* st) {
    XcdBarrier b; b.bar = bar; b.x = xb_xcc_id(); b.st = st;
    if (threadIdx.x == 0) (void)xb_add(&bar[XB_XCNT(b.x)], 1u);
    return b;
}
__device__ __forceinline__ void xcd_barrier_complete(unsigned* bar, unsigned x, unsigned& nloc, unsigned& nx) {
    const unsigned G = gridDim.x * gridDim.y * gridDim.z;
    unsigned sum, cnt, mine, sp = 0u;
    for (;;) {
        sum = 0u; cnt = 0u; mine = 0u;
#pragma unroll
        for (unsigned j = 0; j < 16; ++j) { const unsigned c = xb_ld(&bar[XB_XCNT(j)]); sum += c; cnt += (c > 0u) ? 1u : 0u; mine = (j == x) ? c : mine; }
        if (sum == G) break;
        __builtin_amdgcn_s_sleep(1);
        if ((++sp & 255u) == 0u) { if (xb_ld(&bar[XB_TMO])) break; if (sp > XB_SPIN_CAP) { atomicAdd(&bar[XB_TMO], 1u); break; } }
    }
    nloc = mine > 0u ? mine : 1u; nx = cnt > 0u ? cnt : 1u;
}

__device__ __forceinline__ void xcd_barrier(const XcdBarrier& b) {
    asm volatile("s_waitcnt vmcnt(0)" ::: "memory");
    __syncthreads();
    if (threadIdx.x == 0) {
        unsigned* bar = b.bar;
        __builtin_amdgcn_s_waitcnt(0);
        unsigned nloc = b.st[0], nx = b.st[1];
        if (nloc == 0u) { xcd_barrier_complete(bar, b.x, nloc, nx); b.st[0] = nloc; b.st[1] = nx; }
        const unsigned old = xb_add(&bar[XB_XSUB(b.x)], 1u);
        const unsigned gen = old / nloc;
        if (old + 1u == (gen + 1u) * nloc) {
            __builtin_amdgcn_fence(__ATOMIC_RELEASE, "agent");
            asm volatile("s_waitcnt vmcnt(0)" ::: "memory");
            const unsigned og = xb_add(&bar[XB_TOP], 1u);
            const unsigned tg = og / nx;
            if (og + 1u == (tg + 1u) * nx) xb_add(&bar[XB_TOPGEN], 1u);
            else XB_SPIN(xb_ld(&bar[XB_TOPGEN]) == tg, bar);
            __builtin_amdgcn_fence(__ATOMIC_ACQUIRE, "agent");
            xb_add(&bar[XB_XGEN(b.x)], 1u);
            asm volatile("s_waitcnt vmcnt(0)" ::: "memory");
        } else {
            XB_SPIN(xb_ld(&bar[XB_XGEN(b.x)]) == gen, bar);
            __builtin_amdgcn_fence(__ATOMIC_ACQUIRE, "agent");
            asm volatile("s_waitcnt vmcnt(0)" ::: "memory");
        }
    }
    __syncthreads();
}

__device__ __forceinline__ void build_rstd_table(const pg8::StaticOrder& S, const float* SSQ, LAS unsigned char* lds, int tid) {
    LAS int* PML = (LAS int*)(lds + RING_BYTES + 512); LAS float* RT = (LAS float*)(lds + RING_BYTES + 1024);
    if (tid == 0) {
        int n = 0; pg8::Unit u;
        for (int i = 0; S.next(i, u); ++i) { bool f = false; for (int k = 0; k < n; ++k) f = f || (PML[k] == u.pm); if (!f && n < 8) PML[n++] = u.pm; }
        for (int k = n; k < 8; ++k) PML[k] = -1;
    }
    __syncthreads();
    for (int idx = tid; idx < 8 * 256; idx += NTHREADS) { const int pm = PML[idx >> 8]; if (pm >= 0) RT[idx] = pg8::row_rstd(SSQ, pm * 256 + (idx & 255)); }
    __syncthreads();
}

constexpr int NPHASES = 21;
__global__ void __launch_bounds__(NTHREADS, 2) trunk_fwd(Args args) {
    extern __shared__ __attribute__((aligned(16))) unsigned char lds_raw[];
    LAS unsigned char* lds = (LAS unsigned char*)lds_raw;
    const int tid = threadIdx.x, wave = __builtin_amdgcn_readfirstlane(tid >> 6);
#define lane (tid & 63)
    const int G = gridDim.x, bx = blockIdx.x;
#define gw (bx * NWAVES + wave)
#define ngw (G * NWAVES)
#define gtid (bx * NTHREADS + tid)
#define nthr (G * NTHREADS)
    unsigned char* ws = args.ws;
    float* X = args.out; bf16_t* XB = (bf16_t*)(ws + WS_XB); float* SSQ = (float*)(ws + WS_SSQ);
    bf16_t* BIG = (bf16_t*)(ws + WS_BIG);
    const int lo = args.ph_lo, hi = args.ph_hi;
    unsigned* barw = (unsigned*)ws;
    if (lo == 0) { if (bx == 0) for (int i = tid; i < XCD_BAR_WORDS; i += NTHREADS) barw[i] = 0u; }
    if (tid < 16) ((LAS unsigned*)(lds + RING_BYTES))[tid + 16] = 0u;
    __syncthreads();
    XcdBarrier bar; bar.bar = barw; bar.x = 0; bar.st = (volatile LAS unsigned*)(lds + RING_BYTES + 64);
#ifndef PH_MASK
#define PH_MASK 0x1fffff
#endif
#define IN(k) (((PH_MASK >> (k)) & 1) && lo <= (k) && (k) < hi)
#define GSYNC() xcd_barrier(bar)
#define SEAM(k) do { if (IN(k) && IN((k) + 1)) { if ((k) == 0) { cg::this_grid().sync(); bar = xcd_barrier_post(barw, (volatile LAS unsigned*)(lds + RING_BYTES + 64)); } else { GSYNC(); } } } while (0)
#define RT_PTR ((const LAS float*)(lds + RING_BYTES + 1024))
#define PML_PTR ((const LAS int*)(lds + RING_BYTES + 512))
#define GEMM_PHASE_RS(EPI, g_, e_) do { pg8::StaticOrder S_; S_.init((g_).M, (g_).N, G, bx); build_rstd_table(S_, SSQ, lds, tid); pg8::gemm_phase<EPI, pg8::StaticOrder, true, true>(lds, g_, S_, e_); } while (0)
#define GEMM_PHASE(EPI, g_, e_) do { pg8::StaticOrder S_; S_.init((g_).M, (g_).N, G, bx); pg8::gemm_phase<EPI, pg8::StaticOrder, true, true>(lds, g_, S_, e_); } while (0)

#ifndef REP_MASK
#define REP_MASK 0
#endif
#define RUNPH(k, DRY, REAL) if (IN(k)) { if ((REP_MASK >> (k)) & 1) { DRY; if ((k) == 0) cg::this_grid().sync(); else GSYNC(); } REAL; } SEAM(k);
    RUNPH(0, prologue(args, lds, gw, ngw, wave, lane), prologue(args, lds, gw, ngw, wave, lane))
#define FFN_UP_BODY(f) { pg8::Gemm g{XB, (const bf16_t*)(ws + WS_W + (f) * WS_FFN_STRIDE + WS_W1T_OFF), T_TOK, 2 * DFF, DM, DM, 30, 0}; \
        pg8::EpiGateUp E{BIG, SSQ, RT_PTR, PML_PTR}; GEMM_PHASE_RS(pg8::EpiGateUp, g, E); }
#define FFN_DOWN_BODY(f, sc) { pg8::Gemm g{BIG, (const bf16_t*)(ws + WS_W + (f) * WS_FFN_STRIDE + WS_W2T_OFF), T_TOK, DM, DFF, DFF, 30, 0}; \
        pg8::EpiResid E{XB, SSQ, sc, nullptr, nullptr}; GEMM_PHASE(pg8::EpiResid, g, E); }
#define LATE_CONVERT(lo1, hi1, lo2, hi2) if (bx >= G / 2) { const int w_ = (bx - G / 2) * NWAVES + wave, nw_ = (G - G / 2) * NWAVES; \
        convert_items(args, lds, lo1, hi1, w_, nw_, wave, lane); convert_items(args, lds, lo2, hi2, w_, nw_, wave, lane); }
#define FFN_UP(k, f) RUNPH(k, FFN_UP_BODY(f), FFN_UP_BODY(f))
#define FFN_DOWN(k, f) RUNPH(k, FFN_DOWN_BODY(f, 0.0f), FFN_DOWN_BODY(f, 0.5f))
#define FFN_DOWN0_BODY(sc) { pg8::Gemm g{BIG, (const bf16_t*)(ws + WS_W + WS_W2T_OFF), T_TOK, DM, DFF, DFF, 30, 0}; \
        pg8::EpiResidIn E{XB, SSQ, sc, args.in[0], args.in[1]}; GEMM_PHASE(pg8::EpiResidIn, g, E); }
    RUNPH(1, FFN_UP_BODY(0), { FFN_UP_BODY(0) LATE_CONVERT(4224, 8448, 16896, 18944) })
    RUNPH(2, FFN_DOWN0_BODY(0.0f), FFN_DOWN0_BODY(0.5f))
    bf16_t* AKH = (bf16_t*)X + (size_t)T_TOK * DM; bf16_t* AVH = AKH + (size_t)T_TOK * 512;
#define WIN0_BODY { pg8::Gemm g{XB, (const bf16_t*)(ws + WS_L0WIN), T_TOK, Z0W, DM, DM, 30, 0}; pg8::EpiZ0 E{BIG, SSQ, RT_PTR, PML_PTR, (const float*)(ws + WS_ROPE), AKH, AVH}; GEMM_PHASE_RS(pg8::EpiZ0, g, E); }
    RUNPH(3, WIN0_BODY, WIN0_BODY)
#define ATT1_BODY attn_phase<1, true, false>(lds, BIG, AKH, AVH, X, (float*)(ws + WS_ML), tid);
    RUNPH(4, ATT1_BODY, { conv_gate0(BIG, args.in[8], gtid, nthr); ATT1_BODY })
    if (IN(5)) attn_phase<4, false, false>(lds, BIG, AKH, AVH, X, (float*)(ws + WS_ML), tid);
    SEAM(5);
    if (IN(6)) attn_phase<16, false, true>(lds, BIG, AKH, AVH, X, (float*)(ws + WS_ML), tid);
    SEAM(6);
#define WOUT0_BODY(sc) { pg8::Gemm g{BIG + 1024, (const bf16_t*)(ws + WS_L0WOUT), T_TOK, DM, DM, Z0W, 30, 0}; pg8::EpiResid E{XB, SSQ, sc, nullptr, nullptr}; GEMM_PHASE(pg8::EpiResid, g, E); }
    RUNPH(7, WOUT0_BODY(0.0f), WOUT0_BODY(1.0f))
    RUNPH(8, FFN_UP_BODY(1), { FFN_UP_BODY(1) LATE_CONVERT(8448, 12672, 18944, 20992) }) FFN_DOWN(9, 1)
    RUNPH(10, FFN_UP_BODY(2), { FFN_UP_BODY(2) LATE_CONVERT(12672, 16896, 0, 0) }) FFN_DOWN(11, 2)
    bf16_t* XP = BIG; bf16_t* GG = BIG + (size_t)T_TOK * DM; bf16_t* XBC = BIG + 2 * (size_t)T_TOK * DM; bf16_t* Y1 = XP;
#define WIN1_BODY { pg8::Gemm g{XB, (const bf16_t*)(ws + WS_L1WIN), T_TOK, 2048, DM, DM, 30, 0}; pg8::EpiZ1 E{XP, GG, SSQ, RT_PTR, PML_PTR}; GEMM_PHASE_RS(pg8::EpiZ1, g, E); }
    RUNPH(12, WIN1_BODY, WIN1_BODY)
#define CONV1_BODY conv1(XP, XBC, args.in[20], args.in[21], gtid, nthr);
    RUNPH(13, CONV1_BODY, CONV1_BODY)
    bf16_t* LPF = XP; bf16_t* LPB = (bf16_t*)X; bf16_t* LSS = (bf16_t*)X + (size_t)T_TOK * DM;
    float* LCS = (float*)(ws + WS_W); float* LH0 = (float*)(ws + WS_W + 17 * MiB);
#define LRU_BODY { pg8::Gemm g{XBC, (const bf16_t*)(ws + WS_GATES), T_TOK, 4096, 256, DM, 2, 512}; \
        const float* LRC = (const float*)(ws + WS_LRC); pg8::EpiLru E{XBC, LPF, LPB, LSS, LCS, LRC, LRC + 1024, LRC + 2048, LRC + 3072, LRC + 4096, LRC + 5120}; GEMM_PHASE(pg8::EpiLru, g, E); }
    RUNPH(14, LRU_BODY, LRU_BODY)
#define CARRY_BODY lru_carry(LCS, LH0, lds, tid);
    RUNPH(15, CARRY_BODY, CARRY_BODY)
    if (IN(16)) lru_apply(LPF, LPB, LSS, GG, LH0, gtid, nthr);
    SEAM(16);
    Y1 = LSS;
#define WOUT1_BODY(sc) { pg8::Gemm g{Y1, (const bf16_t*)(ws + WS_L1WOUT), T_TOK, DM, DM, DM, 30, 0}; pg8::EpiResid E{XB, SSQ, sc, nullptr, nullptr}; GEMM_PHASE(pg8::EpiResid, g, E); }
    RUNPH(17, WOUT1_BODY(0.0f), WOUT1_BODY(1.0f))
    FFN_UP(18, 3) FFN_DOWN(19, 3)
    if (IN(20)) final_norm(XB, X, args.in[37], gw, ngw, lane);
#undef lane
#undef gw
#undef ngw
#undef gtid
#undef nthr
#undef IN
#undef SEAM
}

extern "C" void kernel_launch(void* const* d_in, const int* in_sizes, int n_in, void* d_out, int out_size, void* d_ws, size_t ws_size, hipStream_t stream) {
    static int grid = 0;
    if (grid == 0) {
        if (n_in != 38 || out_size != T_TOK * DM || ws_size < WS_END) { fprintf(stderr, "kernel_launch: unexpected shapes (n_in %d, out %d, ws %zu); nothing launched\n", n_in, out_size, ws_size); grid = -1; return; }
        int dev = 0, cus = 0, per_cu = 0;
        if (hipGetDevice(&dev) != hipSuccess || hipDeviceGetAttribute(&cus, hipDeviceAttributeMultiprocessorCount, dev) != hipSuccess) { grid = -1; return; }
        if (hipFuncSetAttribute((const void*)trunk_fwd, hipFuncAttributeMaxDynamicSharedMemorySize, LDS_BYTES) != hipSuccess) { fprintf(stderr, "kernel_launch: hipFuncSetAttribute failed\n"); grid = -1; return; }
        if (hipOccupancyMaxActiveBlocksPerMultiprocessor(&per_cu, (const void*)trunk_fwd, NTHREADS, LDS_BYTES) != hipSuccess || per_cu < 1) { fprintf(stderr, "kernel_launch: occupancy query says %d\n", per_cu); per_cu = 1; }
        (void)hipGetLastError();
        grid = cus * per_cu;
    }
    if (grid < 0) return;
    Args a{};
    for (int i = 0; i < 38; ++i) a.in[i] = (const float*)d_in[i];
    a.out = (float*)d_out; a.ws = (unsigned char*)d_ws;
#if MK_N_LAUNCHES == 1
    a.ph_lo = 0; a.ph_hi = NPHASES;
    void* kargs[] = {&a};
    hipError_t e = hipLaunchCooperativeKernel((const void*)trunk_fwd, dim3(grid), dim3(NTHREADS), kargs, LDS_BYTES, stream);
    if (e != hipSuccess) fprintf(stderr, "cooperative launch failed: %s (grid %d)\n", hipGetErrorString(e), grid);
#else
    for (int k = 0; k < NPHASES; ++k) {
        a.ph_lo = k; a.ph_hi = k + 1;
        hipLaunchKernelGGL(trunk_fwd, dim3(grid), dim3(NTHREADS), LDS_BYTES, stream, a);
    }
#endif
}
```

```cpp
#include <hip/hip_runtime.h>
#include <hip/hip_cooperative_groups.h>
#include <cstdio>
#include <cstdint>
namespace cg = cooperative_groups;

#ifndef MK_N_LAUNCHES
#define MK_N_LAUNCHES 1
#endif

constexpr int T_TOK = 49152, SEQ = 16384, DM = 1024, DFF = 2816, Z0W = 3072;
constexpr float EPS = 1e-6f;

constexpr size_t MiB = 1u << 20;
constexpr size_t WS_ROPE = 1 * MiB;
constexpr size_t WS_SSQ = 2 * MiB;
constexpr size_t WS_LRC = 5 * MiB;
constexpr size_t WS_W = 6 * MiB;
constexpr size_t WS_FFN_STRIDE = 17 * MiB;
constexpr size_t WS_W1T_OFF = 0, WS_W2T_OFF = 11 * MiB;
constexpr size_t WS_L0WIN = 74 * MiB, WS_L0WOUT = 80 * MiB, WS_L1WIN = 82 * MiB, WS_L1WOUT = 86 * MiB, WS_GATES = 88 * MiB;
constexpr size_t WS_XB = 92 * MiB;
constexpr size_t WS_ML = 188 * MiB;
constexpr size_t WS_BIG = 192 * MiB;
constexpr size_t WS_END = 480 * MiB;

namespace pg8 {
#define PG8_LAS __attribute__((address_space(3)))
typedef unsigned short bf16_t;
typedef short bf16x8 __attribute__((ext_vector_type(8)));
typedef float f32x4 __attribute__((ext_vector_type(4)));
typedef unsigned u32x4 __attribute__((ext_vector_type(4)));
constexpr int BM = 256, BK = 64, HALF = 128, HTB = HALF * BK * 2  , STAGE_BYTES = 8 * HTB, NXCD = 8, WGM = 8;

__host__ __device__ __forceinline__ int lds_byte(int r, int c) { const int st = (r >> 4) * 2 + (c >> 5), rr = r & 15, cc = c & 31, ob = rr * 64 + cc * 2; return st * 1024 + (ob ^ (((ob >> 9) & 1) << 5)); }
__host__ __device__ __forceinline__ void stage_rc(int b, int& R, int& C) { const int st = b / 1024, sb = b % 1024, swz = sb ^ (((sb >> 9) & 1) << 5); R = (st >> 1) * 16 + swz / 64; C = (st & 1) * 32 + (swz % 64) / 2; }
__host__ __device__ __forceinline__ int perm32(int rho) { const int n = rho >> 4, i = rho & 15; return 8 * (i >> 2) + 4 * n + (i & 3); }

struct Unit { int pm, pn; };
struct Gemm { const bf16_t* A; const bf16_t* Bt; int M, N, K, lda, ash, astride; };

struct StaticOrder {
    int nM, nN, nwg, G, c;
    __host__ __device__ void init(int M, int N, int G_, int c_) { nM = M / BM; nN = N / BM; nwg = nM * nN; G = G_; c = c_; }
    __host__ __device__ bool next(int i, Unit& u) const {
        const long L = (long)i * G + c; if (L >= nwg) return false;
        int wgid = (int)L; { const int q = nwg / NXCD, r = nwg % NXCD, xcd = wgid % NXCD, off = wgid / NXCD; wgid = (xcd < r ? xcd * (q + 1) : r * (q + 1) + (xcd - r) * q) + off; }
        const int nig = WGM * nN, gid = wgid / nig, fm = gid * WGM, gsz = (nM - fm) < WGM ? (nM - fm) : WGM;
        u.pm = fm + ((wgid % nig) % gsz); u.pn = (wgid % nig) / gsz; return true;
    }
    __device__ __forceinline__ void a_ready(const Unit&) const {}
    __device__ __forceinline__ void done(const Unit&) const {}
};

__device__ __forceinline__ unsigned cvt_pk_bf16(float lo, float hi) { unsigned r; asm("v_cvt_pk_bf16_f32 %0, %1, %2" : "=v"(r) : "v"(lo), "v"(hi)); return r; }

typedef float f32x2 __attribute__((ext_vector_type(2)));
typedef unsigned u32x2 __attribute__((ext_vector_type(2)));
__device__ __forceinline__ float bf2f(unsigned short b) { return __uint_as_float((unsigned)b << 16); }
__device__ __forceinline__ float bflo(unsigned w) { return __uint_as_float(w << 16); }
__device__ __forceinline__ float bfhi(unsigned w) { return __uint_as_float(w & 0xffff0000u); }
__device__ __forceinline__ float row_rstd(const float* SSQ, int row) {
    const f32x4* p = (const f32x4*)(SSQ + (size_t)row * 16);
    const f32x4 a = p[0], b = p[1], c = p[2], d = p[3];
    const float s = ((a[0] + a[1]) + (a[2] + a[3])) + ((b[0] + b[1]) + (b[2] + b[3])) + ((c[0] + c[1]) + (c[2] + c[3])) + ((d[0] + d[1]) + (d[2] + d[3]));
    return __builtin_amdgcn_rsqf(s * (1.0f / 1024.0f) + 1e-6f);
}
__device__ __forceinline__ float fast_sigmoid(float x) { return __builtin_amdgcn_rcpf(1.0f + __builtin_amdgcn_exp2f(-1.4426950408889634f * x)); }
__device__ __forceinline__ float silu_f(float x) { return x * fast_sigmoid(x); }
__device__ __forceinline__ float gelu_tanh_f(float x) {
    const float t = x * __builtin_fmaf(x * x, -0.1029432395800235f, -2.302208198144325f); return x * __builtin_amdgcn_rcpf(1.0f + __builtin_amdgcn_exp2f(t)); }
__device__ __forceinline__ float softplus_neg(float lam) { const float x = __expf(-lam); return (x < 0.03f) ? x * (1.0f - x * (0.5f - x * (0.33333333f - 0.25f * x))) : __logf(1.0f + x); }
template <int CTRL> __device__ __forceinline__ float dppz(float v) {
    return __int_as_float(__builtin_amdgcn_update_dpp(0, __float_as_int(v), CTRL, 0xF, 0xF, true));
}
template <int CTRL> __device__ __forceinline__ float dppf(float old, float v) {
    return __int_as_float(__builtin_amdgcn_update_dpp(__float_as_int(old), __float_as_int(v), CTRL, 0xF, 0xF, false));
}

struct EpiGateUp {
    static constexpr bool PERM = true, AFTER_DRAIN = false, APERM = false;
    bf16_t* H; const float* SSQ; const PG8_LAS float* RT; const PG8_LAS int* PML;
    __device__ __forceinline__ void operator()(f32x4 (&acc)[2][2][4][2], const Unit& u, int wr, int wc, int fr, int fq) const {
        const int row0 = u.pm * BM + wr * 64 + fr; const int col0 = u.pn * 128 + wc * 32 + 8 * fq;
        int slot = -1;
#pragma unroll
        for (int k = 0; k < 8; ++k) slot = (PML[k] == u.pm) ? k : slot;
        float rsv[2][4];
#pragma unroll
        for (int ai = 0; ai < 2; ++ai)
#pragma unroll
            for (int m = 0; m < 4; ++m) rsv[ai][m] = (slot >= 0) ? RT[slot * 256 + ai * HALF + wr * 64 + m * 16 + fr] : row_rstd(SSQ, row0 + ai * HALF + m * 16);
#pragma unroll
        for (int ai = 0; ai < 2; ++ai)
#pragma unroll
            for (int m = 0; m < 4; ++m) {
                const int row = row0 + ai * HALF + m * 16; const float rs = rsv[ai][m]; const float rsl = rs * -1.4426950408889634f, rs2 = rs * rs;
                float h[8];
#pragma unroll
                for (int n = 0; n < 2; ++n)
#pragma unroll
                    for (int e = 0; e < 4; ++e) { const float ag = acc[ai][0][m][n][e], au = acc[ai][1][m][n][e];
                        const float r = __builtin_amdgcn_rcpf(1.0f + __builtin_amdgcn_exp2f(ag * rsl)); h[4 * n + e] = ((ag * au) * rs2) * r; }
                u32x4 w; w.x = cvt_pk_bf16(h[0], h[1]); w.y = cvt_pk_bf16(h[2], h[3]); w.z = cvt_pk_bf16(h[4], h[5]); w.w = cvt_pk_bf16(h[6], h[7]);
                *(u32x4*)(H + (size_t)row * 2816 + col0) = w;
            }
    }
};

template <bool FROM_INPUT> struct EpiResidT {
    static constexpr bool PERM = true, AFTER_DRAIN = false, APERM = false;
    bf16_t* XB; float* SSQ; float scale; const float* X0; const float* X1;
    __device__ __forceinline__ void operator()(f32x4 (&acc)[2][2][4][2], const Unit& u, int wr, int wc, int fr, int fq) const {
        const int row0 = u.pm * BM + wr * 64 + fr; const int col0 = u.pn * BM + wc * 32 + 8 * fq;
#pragma unroll
        for (int ai = 0; ai < 2; ++ai) {
            f32x4 xv[4][2][2];
#pragma unroll
            for (int m = 0; m < 4; ++m) {
                const int row = row0 + ai * HALF + m * 16;
                if (FROM_INPUT) {
                    const float* xs = (row < 16384 ? X0 + (size_t)row * 1024 : X1 + (size_t)(row - 16384) * 1024) + col0;
#pragma unroll
                    for (int bj = 0; bj < 2; ++bj) { xv[m][bj][0] = *(const f32x4*)(xs + bj * HALF); xv[m][bj][1] = *(const f32x4*)(xs + bj * HALF + 4); }
                } else {
#pragma unroll
                    for (int bj = 0; bj < 2; ++bj) { const u32x4 w = *(const u32x4*)(XB + (size_t)row * 1024 + col0 + bj * HALF);
                        xv[m][bj][0] = (f32x4){bflo(w.x), bfhi(w.x), bflo(w.y), bfhi(w.y)}; xv[m][bj][1] = (f32x4){bflo(w.z), bfhi(w.z), bflo(w.w), bfhi(w.w)}; }
                }
            }
#pragma unroll
            for (int m = 0; m < 4; ++m) {
                const int row = row0 + ai * HALF + m * 16; float ss = 0.f;
#pragma unroll
                for (int bj = 0; bj < 2; ++bj) {
                    const f32x4 x0 = xv[m][bj][0] + acc[ai][bj][m][0] * scale, x1 = xv[m][bj][1] + acc[ai][bj][m][1] * scale;
                    ss += (x0[0] * x0[0] + x0[1] * x0[1]) + (x0[2] * x0[2] + x0[3] * x0[3]) + (x1[0] * x1[0] + x1[1] * x1[1]) + (x1[2] * x1[2] + x1[3] * x1[3]);
                    u32x4 w; w.x = cvt_pk_bf16(x0[0], x0[1]); w.y = cvt_pk_bf16(x0[2], x0[3]); w.z = cvt_pk_bf16(x1[0], x1[1]); w.w = cvt_pk_bf16(x1[2], x1[3]);
                    *(u32x4*)(XB + (size_t)row * 1024 + col0 + bj * HALF) = w;
                }
                ss += __shfl_xor(ss, 16); ss += __shfl_xor(ss, 32);
                if (fq == 0) SSQ[(size_t)row * 16 + u.pn * 4 + wc] = ss;
            }
        }
    }
};
typedef EpiResidT<false> EpiResid;
typedef EpiResidT<true> EpiResidIn;

struct EpiZ0 {
    static constexpr bool PERM = true, AFTER_DRAIN = false, APERM = false;
    bf16_t* Z; const float* SSQ; const PG8_LAS float* RT; const PG8_LAS int* PML; const float* ROPE; bf16_t* KH; bf16_t* VH;
    __device__ __forceinline__ void operator()(f32x4 (&acc)[2][2][4][2], const Unit& u, int wr, int wc, int fr, int fq) const {
        const int row0 = u.pm * BM + wr * 64 + fr; const int col0 = u.pn * BM + wc * 32 + 8 * fq;
        const bool rope = (u.pn >= 6) && (u.pn <= 9) && ((wc & 1) == 0);
        int slot = -1;
#pragma unroll
        for (int k = 0; k < 8; ++k) slot = (PML[k] == u.pm) ? k : slot;
        float rsv[2][4];
#pragma unroll
        for (int ai = 0; ai < 2; ++ai)
#pragma unroll
            for (int m = 0; m < 4; ++m) rsv[ai][m] = (slot >= 0) ? RT[slot * 256 + ai * HALF + wr * 64 + m * 16 + fr] : row_rstd(SSQ, row0 + ai * HALF + m * 16);
        f32x4 bc0 = {1.f, 1.f, 1.f, 1.f}, bc1 = bc0, bs0 = {0.f, 0.f, 0.f, 0.f}, bs1 = bs0;
        if (rope) { const f32x4* rp = (const f32x4*)(ROPE + (size_t)(row0 & (SEQ - 1)) * 16); bc0 = rp[0]; bc1 = rp[1]; bs0 = rp[2]; bs1 = rp[3]; }
        const f32x4 C16a = {-9.576594803e-01f, -9.992462593e-01f, 8.243765146e-01f, 9.932003012e-01f}, C16b = {9.997440109e-01f, 9.999903729e-01f, 9.999996380e-01f, 9.999999864e-01f};
        const f32x4 S16a = {-2.879033167e-01f, 3.881898152e-02f, 5.660418378e-01f, 1.164180468e-01f}, S16b = {2.262548617e-02f, 4.387956730e-03f, 8.509272408e-04f, 1.650141653e-04f};
        const f32x4 C128a = {-6.928958219e-01f, 9.521412243e-01f, 1.010104153e-01f, 5.950559312e-01f}, C128b = {9.836606904e-01f, 9.993839261e-01f, 9.999768296e-01f, 9.999991287e-01f};
        const f32x4 S128a = {7.210377105e-01f, -3.056584516e-01f, -9.948853683e-01f, 8.036842905e-01f}, S128b = {1.800323475e-01f, 3.509655735e-02f, 6.807366171e-03f, 1.320112945e-03f};
        f32x4 c0 = bc0, c1 = bc1, s0 = bs0, s1 = bs1;
#pragma unroll
        for (int ai = 0; ai < 2; ++ai)
#pragma unroll
            for (int m = 0; m < 4; ++m) {
                const int row = row0 + ai * HALF + m * 16; const float rs = rsv[ai][m];
                if (rope) {
                    if (m == 0 && ai == 1) { c0 = bc0 * C128a - bs0 * S128a; s0 = bs0 * C128a + bc0 * S128a; c1 = bc1 * C128b - bs1 * S128b; s1 = bs1 * C128b + bc1 * S128b; }
                    else if (m > 0) { const f32x4 t0 = c0 * C16a - s0 * S16a, t1 = c1 * C16b - s1 * S16b; s0 = s0 * C16a + c0 * S16a; s1 = s1 * C16b + c1 * S16b; c0 = t0; c1 = t1; }
                }
#pragma unroll
                for (int bj = 0; bj < 2; ++bj) {
                    f32x4 v0 = acc[ai][bj][m][0] * rs, v1 = acc[ai][bj][m][1] * rs;
                    if (rope) {
                        f32x4 p0, p1;
#pragma unroll
                        for (int e = 0; e < 4; ++e) { p0[e] = __shfl_xor(v0[e], 16); p1[e] = __shfl_xor(v1[e], 16); }
                        const float sg = (fq == 0) ? -1.f : 1.f;
                        if (fq < 2) { v0 = v0 * c0 + p0 * s0 * sg; v1 = v1 * c1 + p1 * s1 * sg; }
                    }
                    u32x4 w; w.x = cvt_pk_bf16(v0[0], v0[1]); w.y = cvt_pk_bf16(v0[2], v0[3]); w.z = cvt_pk_bf16(v1[0], v1[1]); w.w = cvt_pk_bf16(v1[2], v1[3]);
                    if (u.pn >= 8) {
                        const int cc = col0 + bj * HALF - 2048, hd = (cc & 511) >> 6, d0 = cc & 63;
                        bf16_t* dst = (cc < 512 ? KH : VH) + ((size_t)((row >> 14) * 8 + hd) * SEQ + (row & (SEQ - 1))) * 64 + d0;
                        *(u32x4*)dst = w;
                    } else *(u32x4*)(Z + (size_t)row * 3072 + col0 + bj * HALF) = w;
                }
            }
    }
};

struct EpiZ1 {
    static constexpr bool PERM = true, AFTER_DRAIN = false, APERM = false;
    bf16_t* XP; bf16_t* GG; const float* SSQ; const PG8_LAS float* RT; const PG8_LAS int* PML;
    __device__ __forceinline__ void operator()(f32x4 (&acc)[2][2][4][2], const Unit& u, int wr, int wc, int fr, int fq) const {
        const int row0 = u.pm * BM + wr * 64 + fr; const bool gate = u.pn >= 4;
        bf16_t* base = gate ? GG : XP; const int col0 = (u.pn & 3) * BM + wc * 32 + 8 * fq;
        int slot = -1;
#pragma unroll
        for (int k = 0; k < 8; ++k) slot = (PML[k] == u.pm) ? k : slot;
        float rsv[2][4];
#pragma unroll
        for (int ai = 0; ai < 2; ++ai)
#pragma unroll
            for (int m = 0; m < 4; ++m) rsv[ai][m] = (slot >= 0) ? RT[slot * 256 + ai * HALF + wr * 64 + m * 16 + fr] : row_rstd(SSQ, row0 + ai * HALF + m * 16);
#pragma unroll
        for (int ai = 0; ai < 2; ++ai)
#pragma unroll
            for (int m = 0; m < 4; ++m) {
                const int row = row0 + ai * HALF + m * 16; const float rs = rsv[ai][m];
#pragma unroll
                for (int bj = 0; bj < 2; ++bj) {
                    f32x4 v0 = acc[ai][bj][m][0] * rs, v1 = acc[ai][bj][m][1] * rs;
                    if (gate) {
#pragma unroll
                        for (int e = 0; e < 4; ++e) { v0[e] = gelu_tanh_f(v0[e]); v1[e] = gelu_tanh_f(v1[e]); }
                    }
                    u32x4 w; w.x = cvt_pk_bf16(v0[0], v0[1]); w.y = cvt_pk_bf16(v0[2], v0[3]); w.z = cvt_pk_bf16(v1[0], v1[1]); w.w = cvt_pk_bf16(v1[2], v1[3]);
                    *(u32x4*)(base + (size_t)row * 1024 + col0 + bj * HALF) = w;
                }
            }
    }
};

struct EpiLru {
    static constexpr bool PERM = true, AFTER_DRAIN = false, APERM = true;
    const bf16_t* XBC; bf16_t* PF; bf16_t* PB; bf16_t* SS; float* CS;
    const float *ba_f, *bi_f, *lam_f, *ba_b, *bi_b, *lam_b;
    template <int DIR>
    __device__ __forceinline__ void one_dir(f32x4 (&acc)[2][2][4][2], const Unit& u, int wr, int fr, int ch0, const u32x2 (&xin)[2][4], f32x4 ba, f32x4 bi, f32x4 sp) const {
#pragma unroll
        for (int ai = 0; ai < 2; ++ai) {
            __builtin_amdgcn_sched_barrier(0);
            const int rowb = u.pm * BM + ai * HALF + wr * 64; const int chunk = rowb >> 6;
            const unsigned ro = (unsigned)(rowb + 4 * fr) * 1024u + (unsigned)ch0;
#pragma unroll
            for (int m = 0; m < 4; ++m) {
                const u32x2 xv = xin[ai][m];
                const float x[4] = {bflo(xv.x), bfhi(xv.x), bflo(xv.y), bfhi(xv.y)};
#pragma unroll
                for (int e = 0; e < 4; ++e) {
                    const float r = __builtin_amdgcn_rcpf(1.0f + __builtin_amdgcn_exp2f(__builtin_fmaf(acc[ai][DIR][m][0][e], -1.4426950408889634f, ba[e])));
                    const float ig = __builtin_amdgcn_rcpf(1.0f + __builtin_amdgcn_exp2f(__builtin_fmaf(acc[ai][DIR][m][1][e], -1.4426950408889634f, bi[e])));
                    const float av = __builtin_amdgcn_exp2f(r * sp[e]);
                    acc[ai][DIR][m][0][e] = av; acc[ai][DIR][m][1][e] = __builtin_amdgcn_sqrtf(__builtin_fmaf(-av, av, 1.0f)) * ig * x[e];
                }
            }
            __builtin_amdgcn_sched_barrier(0);
#pragma unroll
            for (int mm = 1; mm < 4; ++mm) {
                const int m = DIR ? 3 - mm : mm, mp = DIR ? m + 1 : m - 1;
                acc[ai][DIR][m][1] = acc[ai][DIR][m][0] * acc[ai][DIR][mp][1] + acc[ai][DIR][m][1];
                acc[ai][DIR][m][0] = acc[ai][DIR][m][0] * acc[ai][DIR][mp][0];
            }
            f32x4 IP = acc[ai][DIR][DIR ? 0 : 3][0], IS = acc[ai][DIR][DIR ? 0 : 3][1];
#pragma unroll
            for (int e = 0; e < 4; ++e) {
                float p = IP[e], s = IS[e], pp, sq;
                if (DIR == 0) {
                    pp = dppf<0x111>(1.f, p); sq = dppz<0x111>(s); s = p * sq + s; p = p * pp;
                    pp = dppf<0x112>(1.f, p); sq = dppz<0x112>(s); s = p * sq + s; p = p * pp;
                    pp = dppf<0x114>(1.f, p); sq = dppz<0x114>(s); s = p * sq + s; p = p * pp;
                    pp = dppf<0x118>(1.f, p); sq = dppz<0x118>(s); s = p * sq + s; p = p * pp;
                } else {
                    pp = dppf<0x101>(1.f, p); sq = dppz<0x101>(s); s = p * sq + s; p = p * pp;
                    pp = dppf<0x102>(1.f, p); sq = dppz<0x102>(s); s = p * sq + s; p = p * pp;
                    pp = dppf<0x104>(1.f, p); sq = dppz<0x104>(s); s = p * sq + s; p = p * pp;
                    pp = dppf<0x108>(1.f, p); sq = dppz<0x108>(s); s = p * sq + s; p = p * pp;
                }
                IP[e] = p; IS[e] = s;
            }
            if (fr == (DIR ? 0 : 15)) { float* cs = CS + ((unsigned)chunk * 4096u + (unsigned)(DIR * 2048 + ch0)); *(f32x4*)(cs) = IP; *(f32x4*)(cs + 1024) = IS; }
            f32x4 EP, ES;
#pragma unroll
            for (int e = 0; e < 4; ++e) { EP[e] = DIR ? dppf<0x101>(1.f, IP[e]) : dppf<0x111>(1.f, IP[e]); ES[e] = DIR ? dppz<0x101>(IS[e]) : dppz<0x111>(IS[e]); }
#pragma unroll
            for (int m = 0; m < 4; ++m) {
                const f32x4 pf = acc[ai][DIR][m][0] * EP, sf = acc[ai][DIR][m][0] * ES + acc[ai][DIR][m][1];
                u32x2 w; w.x = cvt_pk_bf16(pf[0], pf[1]); w.y = cvt_pk_bf16(pf[2], pf[3]);
                *(u32x2*)((DIR ? PB : PF) + (ro + 1024u * m)) = w;
                if (DIR == 0) acc[ai][0][m][1] = sf;
                else { const f32x4 ssum = acc[ai][0][m][1] + sf; u32x2 v; v.x = cvt_pk_bf16(ssum[0], ssum[1]); v.y = cvt_pk_bf16(ssum[2], ssum[3]); *(u32x2*)(SS + (ro + 1024u * m)) = v; }
            }
        }
    }
    __device__ __forceinline__ void operator()(f32x4 (&acc)[2][2][4][2], const Unit& u, int wr, int wc, int fr, int fq) const {
        const int g = u.pn >> 2, sub = u.pn & 3;
        const int ch0 = 256 * g + 64 * sub + 16 * wc + 4 * fq;
        u32x2 xin[2][4];
#pragma unroll
        for (int ai = 0; ai < 2; ++ai)
#pragma unroll
            for (int m = 0; m < 4; ++m) xin[ai][m] = *(const u32x2*)(XBC + ((unsigned)(u.pm * BM + ai * HALF + wr * 64 + 4 * fr + m) * 1024u + (unsigned)ch0));
        f32x4 baf = *(const f32x4*)(ba_f + ch0), bif = *(const f32x4*)(bi_f + ch0), spf = *(const f32x4*)(lam_f + ch0);
        f32x4 bab = *(const f32x4*)(ba_b + ch0), bib = *(const f32x4*)(bi_b + ch0), spb = *(const f32x4*)(lam_b + ch0);
        one_dir<0>(acc, u, wr, fr, ch0, xin, baf, bif, spf);
        __builtin_amdgcn_sched_barrier(0);
        one_dir<1>(acc, u, wr, fr, ch0, xin, bab, bib, spb);
    }
};


template <class Epi, class Sched, bool ALIGN_EPI = false, bool SP2 = false>
__device__ __forceinline__ void gemm_phase(PG8_LAS unsigned char* lds, const Gemm g, const Sched& S, const Epi& E) {
    const int tid = threadIdx.x, wid = __builtin_amdgcn_readfirstlane(tid >> 6), lane = tid & 63, wr = wid >> 2, wc = wid & 3, fr = lane & 15, fq = lane >> 4;
    const int K = g.K, nt = K / BK;
    unsigned voffA[2], voffB[2];
#pragma unroll
    for (int i = 0; i < 2; ++i) { int R, C; stage_rc(tid * 16 + i * 8192, R, C); const int Rb = Epi::PERM ? ((R & ~31) + perm32(R & 31)) : R;
        const int Ra = Epi::APERM ? ((R & 64) + 4 * (R & 15) + ((R >> 4) & 3)) : R; voffA[i] = (unsigned)(Ra * g.lda + C) * 2u; voffB[i] = (unsigned)(Rb * K + C) * 2u; }
    const size_t kstep = (size_t)(BK * 2);
    const size_t hstepB = (size_t)HALF * K * 2, hstepA = (size_t)HALF * g.lda * 2;
    const size_t tstepB = 2 * hstepB, tstepA = 2 * hstepA;
    const unsigned ldsw = (unsigned)wid * 1024u;
    const int aoff = lds_byte(wr * 64 + fr, fq * 8), boff = lds_byte(wc * 32 + fr, fq * 8);
#define PG8_SA(b, h) (((b) * 2 + (h)) * HTB)
#define PG8_SB(b, h) ((4 + (b) * 2 + (h)) * HTB)
#define PG8_STAGE(bufoff, gbase, voff) do { _Pragma("unroll") for (int _i = 0; _i < 2; ++_i) \
        __builtin_amdgcn_global_load_lds((const unsigned*)((const char*)(gbase) + (voff)[_i]), (PG8_LAS unsigned*)(lds + (bufoff) + ldsw + _i * 8192), 16, 0, 0); } while (0)
#define PG8_LDA(dst, b, h) do { _Pragma("unroll") for (int m = 0; m < 4; ++m) _Pragma("unroll") for (int k = 0; k < 2; ++k) dst[m][k] = *(const PG8_LAS bf16x8*)(lds + PG8_SA(b, h) + aoff + m * 2048 + k * 1024); } while (0)
#define PG8_LDB(dst, b, h) do { _Pragma("unroll") for (int n = 0; n < 2; ++n) _Pragma("unroll") for (int k = 0; k < 2; ++k) dst[n][k] = *(const PG8_LAS bf16x8*)(lds + PG8_SB(b, h) + boff + n * 2048 + k * 1024); } while (0)
#define PG8_MMA(ai, bj, At, Bt) do { __builtin_amdgcn_s_setprio(1); _Pragma("unroll") for (int m = 0; m < 4; ++m) _Pragma("unroll") for (int n = 0; n < 2; ++n) _Pragma("unroll") for (int k = 0; k < 2; ++k) \
        acc[ai][bj][m][n] = __builtin_amdgcn_mfma_f32_16x16x32_bf16(Bt[n][k], At[m][k], acc[ai][bj][m][n], 0, 0, 0); __builtin_amdgcn_s_setprio(0); } while (0)
#define PG8_WAIT_V(n) asm volatile("s_waitcnt vmcnt(" #n ")" ::: "memory")
#define PG8_WAIT_L(n) asm volatile("s_waitcnt lgkmcnt(" #n ")" ::: "memory")
#define PG8_BAR __builtin_amdgcn_s_barrier()
#define PG8_SCHED __builtin_amdgcn_sched_barrier(0)
    Unit cur, nxt; int ui = 0;
    if (!S.next(0, cur)) return;
    f32x4 acc[2][2][4][2];
#pragma unroll
    for (int a = 0; a < 2; ++a)
#pragma unroll
        for (int b = 0; b < 2; ++b)
#pragma unroll
            for (int m = 0; m < 4; ++m)
#pragma unroll
                for (int n = 0; n < 2; ++n) acc[a][b][m][n] = (f32x4){0.f, 0.f, 0.f, 0.f};
    bf16x8 At[4][2], B0[2][2], B1[2][2];
    const char* cA = (const char*)g.A + (size_t)cur.pm * tstepA + (size_t)(cur.pn >> g.ash) * (size_t)g.astride; const char* cB = (const char*)g.Bt + (size_t)cur.pn * tstepB;
    S.a_ready(cur);
    if constexpr (SP2) {
        PG8_STAGE(PG8_SB(0, 0), cB, voffB); PG8_STAGE(PG8_SB(0, 1), cB + hstepB, voffB); PG8_STAGE(PG8_SA(0, 0), cA, voffA); PG8_STAGE(PG8_SA(0, 1), cA + hstepA, voffA);
        if (wr == 1) PG8_BAR;
        PG8_WAIT_V(2); PG8_BAR;
        PG8_STAGE(PG8_SB(1, 0), cB + kstep, voffB); PG8_STAGE(PG8_SA(1, 0), cA + kstep, voffA); PG8_STAGE(PG8_SB(1, 1), cB + hstepB + kstep, voffB);
        PG8_WAIT_V(6); PG8_BAR;
    } else {
        PG8_STAGE(PG8_SB(0, 0), cB, voffB); PG8_STAGE(PG8_SA(0, 0), cA, voffA); PG8_STAGE(PG8_SB(0, 1), cB + hstepB, voffB); PG8_STAGE(PG8_SA(0, 1), cA + hstepA, voffA);
        if (wr == 1) PG8_BAR;
        PG8_WAIT_V(4); PG8_BAR;
        PG8_STAGE(PG8_SB(1, 0), cB + kstep, voffB); PG8_STAGE(PG8_SA(1, 0), cA + kstep, voffA); PG8_STAGE(PG8_SB(1, 1), cB + hstepB + kstep, voffB);
        PG8_WAIT_V(6); PG8_BAR;
    }
    for (;;) {
        const bool has_next = S.next(ui + 1, nxt);
        const char* nA = has_next ? (const char*)g.A + (size_t)nxt.pm * tstepA + (size_t)(nxt.pn >> g.ash) * (size_t)g.astride : cA; const char* nB = has_next ? (const char*)g.Bt + (size_t)nxt.pn * tstepB : cB;
        _Pragma("nounroll") for (int t = 0; t < nt; t += 2) {
            const bool last = (t == nt - 2);
            const char* a1 = cA + (size_t)(t + 1) * kstep;
            const char* a2 = last ? nA : cA + (size_t)(t + 2) * kstep; const char* b2 = last ? nB : cB + (size_t)(t + 2) * kstep;
            const char* a3 = a2 + kstep; const char* b3 = b2 + kstep;
            if (last && has_next) S.a_ready(nxt);
            if constexpr (SP2) {
            PG8_LDB(B0, 0, 0); PG8_LDB(B1, 0, 1); PG8_SCHED; PG8_LDA(At, 0, 0); PG8_STAGE(PG8_SA(1, 1), a1 + hstepA, voffA);
            PG8_WAIT_V(8); PG8_WAIT_L(0); PG8_BAR; PG8_MMA(0, 0, At, B0); PG8_MMA(0, 1, At, B1); PG8_BAR; PG8_SCHED;
            PG8_LDA(At, 0, 1); PG8_STAGE(PG8_SB(0, 0), b2, voffB); PG8_STAGE(PG8_SB(0, 1), b2 + hstepB, voffB); PG8_STAGE(PG8_SA(0, 0), a2, voffA);
            PG8_WAIT_V(8); PG8_WAIT_L(0); PG8_BAR; PG8_MMA(1, 0, At, B0); PG8_MMA(1, 1, At, B1); PG8_BAR; PG8_SCHED;
            PG8_LDB(B0, 1, 0); PG8_LDB(B1, 1, 1); PG8_SCHED; PG8_LDA(At, 1, 0); PG8_STAGE(PG8_SA(0, 1), a2 + hstepA, voffA);
            PG8_WAIT_V(8); PG8_WAIT_L(0); PG8_BAR; PG8_MMA(0, 0, At, B0); PG8_MMA(0, 1, At, B1); PG8_BAR; PG8_SCHED;
            PG8_LDA(At, 1, 1); PG8_STAGE(PG8_SB(1, 0), b3, voffB); PG8_STAGE(PG8_SB(1, 1), b3 + hstepB, voffB); PG8_STAGE(PG8_SA(1, 0), a3, voffA);
            PG8_WAIT_V(8); PG8_WAIT_L(0); PG8_BAR; PG8_MMA(1, 0, At, B0); PG8_MMA(1, 1, At, B1); PG8_BAR; PG8_SCHED;
            } else {
            PG8_LDB(B0, 0, 0); PG8_SCHED; PG8_LDA(At, 0, 0); PG8_STAGE(PG8_SA(1, 1), a1 + hstepA, voffA);
            PG8_WAIT_L(8); PG8_BAR; PG8_WAIT_L(0); PG8_MMA(0, 0, At, B0); PG8_BAR; PG8_SCHED;
            PG8_LDB(B1, 0, 1); PG8_STAGE(PG8_SB(0, 0), b2, voffB);
            PG8_BAR; PG8_WAIT_L(0); PG8_MMA(0, 1, At, B1); PG8_BAR;
            PG8_LDA(At, 0, 1); PG8_STAGE(PG8_SA(0, 0), a2, voffA);
            PG8_BAR; PG8_WAIT_L(0); PG8_MMA(1, 0, At, B0); PG8_BAR; PG8_SCHED;
            PG8_STAGE(PG8_SB(0, 1), b2 + hstepB, voffB);
            PG8_WAIT_V(6); PG8_BAR; PG8_MMA(1, 1, At, B1); PG8_BAR;
            PG8_LDB(B0, 1, 0); PG8_SCHED; PG8_LDA(At, 1, 0); PG8_STAGE(PG8_SA(0, 1), a2 + hstepA, voffA);
            PG8_WAIT_L(8); PG8_BAR; PG8_WAIT_L(0); PG8_MMA(0, 0, At, B0); PG8_BAR; PG8_SCHED;
            PG8_LDB(B1, 1, 1); PG8_STAGE(PG8_SB(1, 0), b3, voffB);
            PG8_BAR; PG8_WAIT_L(0); PG8_MMA(0, 1, At, B1); PG8_BAR;
            PG8_LDA(At, 1, 1); PG8_STAGE(PG8_SA(1, 0), a3, voffA);
            PG8_BAR; PG8_WAIT_L(0); PG8_MMA(1, 0, At, B0); PG8_BAR; PG8_SCHED;
            PG8_STAGE(PG8_SB(1, 1), b3 + hstepB, voffB);
            PG8_WAIT_V(6); PG8_BAR; PG8_MMA(1, 1, At, B1); PG8_BAR;
            }
        }
        if constexpr (ALIGN_EPI) { if (wr == 0) PG8_BAR; }
        if constexpr (!Epi::AFTER_DRAIN) { E(acc, cur, wr, wc, fr, fq); S.done(cur); }
        if (!has_next) break;
#pragma unroll
        for (int a = 0; a < 2; ++a)
#pragma unroll
            for (int b = 0; b < 2; ++b)
#pragma unroll
                for (int m = 0; m < 4; ++m)
#pragma unroll
                    for (int n = 0; n < 2; ++n) acc[a][b][m][n] = (f32x4){0.f, 0.f, 0.f, 0.f};
        cur = nxt; cA = nA; cB = nB; ++ui;
        if constexpr (ALIGN_EPI) { if (wr == 1) PG8_BAR; }
    }
    PG8_WAIT_V(0);
    if constexpr (!ALIGN_EPI) { if (wr == 0) PG8_BAR; }
    PG8_BAR;
    if constexpr (Epi::AFTER_DRAIN) { E.fused(acc, cur, wr, wc, fr, fq, lds, wid, lane); S.done(cur); }
#undef PG8_SA
#undef PG8_SB
#undef PG8_STAGE
#undef PG8_LDA
#undef PG8_LDB
#undef PG8_MMA
#undef PG8_WAIT_V
#undef PG8_WAIT_L
#undef PG8_BAR
#undef PG8_SCHED
}
}


#define LAS __attribute__((address_space(3)))
using pg8::bf16_t; using pg8::bf16x8; using pg8::f32x4; using pg8::u32x4; using pg8::f32x2; using pg8::u32x2; using pg8::cvt_pk_bf16; using pg8::bflo; using pg8::bfhi;
typedef short s16x4 __attribute__((ext_vector_type(4)));
typedef short v4i16_t __attribute__((ext_vector_type(4)));
constexpr int NTHREADS = 512, NWAVES = 8;
constexpr int RING_BYTES = 131072, LDS_BYTES = 147456;
#define LDS_WAIT() asm volatile("s_waitcnt lgkmcnt(0)" ::: "memory")

__device__ __forceinline__ float wave_sum(float v) {
#pragma unroll
    for (int o = 1; o < 64; o <<= 1) v += __shfl_xor(v, o);
    return v;
}

template <class RowMap>
__device__ __forceinline__ void transpose_item(const float* W, int N, int K, const float* gain, bf16_t* WT, RowMap rm, LAS float* scr, int kb, int nb, int lane) {
    const int k0 = 64 * kb, n0 = 32 * nb;
    float v[32];
#pragma unroll
    for (int i = 0; i < 32; ++i) { const int kk = 2 * i + (lane >> 5); v[i] = W[(size_t)(k0 + kk) * N + n0 + (lane & 31)]; }
    if (gain) {
        float gv[32];
#pragma unroll
        for (int i = 0; i < 32; ++i) gv[i] = gain[k0 + 2 * i + (lane >> 5)];
#pragma unroll
        for (int i = 0; i < 32; ++i) v[i] *= gv[i];
    }
#pragma unroll
    for (int i = 0; i < 32; ++i) { const int kk = 2 * i + (lane >> 5); scr[kk * 33 + (lane & 31)] = v[i]; }
    LDS_WAIT(); asm volatile("" ::: "memory");
    const int c = lane & 7;
#pragma unroll
    for (int j = 0; j < 4; ++j) { const int n = (lane >> 3) + 8 * j; const LAS float* s = scr + (8 * c) * 33 + n;
        u32x4 o; o.x = cvt_pk_bf16(s[0 * 33], s[1 * 33]); o.y = cvt_pk_bf16(s[2 * 33], s[3 * 33]); o.z = cvt_pk_bf16(s[4 * 33], s[5 * 33]); o.w = cvt_pk_bf16(s[6 * 33], s[7 * 33]);
        *(u32x4*)(WT + (size_t)rm(n0 + n) * K + k0 + 8 * c) = o; }
    LDS_WAIT(); asm volatile("" ::: "memory");
}
struct RmId { __device__ __forceinline__ int operator()(int n) const { return n; } };
struct RmGateUp { int off; __device__ __forceinline__ int operator()(int n) const { return 256 * (n >> 7) + (n & 127) + off; } };
struct RmWin0 { __device__ __forceinline__ int operator()(int n) const { return (n >= 512 && n < 1024) ? n + 512 : ((n >= 1024 && n < 1536) ? n - 512 : n); } };
struct RmLruGate { int g, gate; __device__ __forceinline__ int operator()(int n) const {
    return (4 * g + (n >> 6)) * 256 + 128 * (gate >> 1) + 32 * ((n >> 4) & 3) + 8 * ((n >> 2) & 3) + 4 * (gate & 1) + (n & 3); } };

struct Args { const float* in[38]; float* out; unsigned char* ws; int ph_lo, ph_hi; };

__device__ __forceinline__ void convert_items(const Args& a, LAS unsigned char* lds, int it_lo, int it_hi, int w, int nw, int wave, int lane) {
    unsigned char* ws = a.ws;
    LAS float* scr = (LAS float*)(lds + wave * 16384);
    constexpr int I_GU = 16 * 88, I_DN = 44 * 32, I_FFN = 2 * I_GU + I_DN;
    constexpr int I_WIN0 = 16 * 96, I_SQ = 16 * 32, I_WIN1 = 16 * 64, I_GATE = 4 * 8;
    constexpr int NITEMS = 4 * I_FFN + I_WIN0 + I_SQ + I_WIN1 + I_SQ + 16 * I_GATE;
    for (int it = it_lo + w; it < it_hi; it += nw) {
        int r = it;
        if (r < 4 * I_FFN) {
            const int f = r / I_FFN; r -= f * I_FFN;
            const float* nrm = (f == 0) ? a.in[2] : (f == 1) ? a.in[10] : (f == 2) ? a.in[14] : a.in[33];
            const float* wg = (f == 0) ? a.in[3] : (f == 1) ? a.in[11] : (f == 2) ? a.in[15] : a.in[34];
            const float* wu = (f == 0) ? a.in[4] : (f == 1) ? a.in[12] : (f == 2) ? a.in[16] : a.in[35];
            const float* wd = (f == 0) ? a.in[5] : (f == 1) ? a.in[13] : (f == 2) ? a.in[17] : a.in[36];
            bf16_t* W1t = (bf16_t*)(ws + WS_W + f * WS_FFN_STRIDE + WS_W1T_OFF); bf16_t* W2t = (bf16_t*)(ws + WS_W + f * WS_FFN_STRIDE + WS_W2T_OFF);
            if (r < I_GU) { transpose_item(wg, DFF, DM, nrm, W1t, RmGateUp{0}, scr, r / 88, r % 88, lane); continue; } r -= I_GU;
            if (r < I_GU) { transpose_item(wu, DFF, DM, nrm, W1t, RmGateUp{128}, scr, r / 88, r % 88, lane); continue; } r -= I_GU;
            transpose_item(wd, DM, DFF, nullptr, W2t, RmId{}, scr, r / 32, r % 32, lane); continue;
        }
        r -= 4 * I_FFN;
        if (r < I_WIN0) { transpose_item(a.in[7], Z0W, DM, a.in[6], (bf16_t*)(ws + WS_L0WIN), RmWin0{}, scr, r / 96, r % 96, lane); continue; } r -= I_WIN0;
        if (r < I_SQ) { transpose_item(a.in[9], DM, DM, nullptr, (bf16_t*)(ws + WS_L0WOUT), RmId{}, scr, r / 32, r % 32, lane); continue; } r -= I_SQ;
        if (r < I_WIN1) { transpose_item(a.in[19], 2048, DM, a.in[18], (bf16_t*)(ws + WS_L1WIN), RmId{}, scr, r / 64, r % 64, lane); continue; } r -= I_WIN1;
        if (r < I_SQ) { transpose_item(a.in[32], DM, DM, nullptr, (bf16_t*)(ws + WS_L1WOUT), RmId{}, scr, r / 32, r % 32, lane); continue; } r -= I_SQ;
        {
            const int mat = r / I_GATE; r -= mat * I_GATE;
            const int gate = mat >> 2, g = mat & 3;
            const float* src = (gate == 0) ? a.in[22] : (gate == 1) ? a.in[24] : (gate == 2) ? a.in[27] : a.in[29];
            transpose_item(src + (size_t)g * 65536, 256, 256, nullptr, (bf16_t*)(ws + WS_GATES), RmLruGate{g, gate}, scr, r / 8, r % 8, lane);
        }
    }
}

__device__ __forceinline__ void prologue(const Args& a, LAS unsigned char* lds, int gw, int ngw, int wave, int lane) {
    unsigned char* ws = a.ws;
    {
        float* R = (float*)(ws + WS_ROPE);
        for (int idx = gw * 64 + lane; idx < SEQ * 8; idx += ngw * 64) {
            const int pos = idx >> 3, i = idx & 7;
            const double f = (i == 0) ? 1.0 : (i == 1) ? 0.19392274474868576 : (i == 2) ? 0.03760603093086393 : (i == 3) ? 0.007292664737217109 :
                             (i == 4) ? 0.001414213562373095 : (i == 5) ? 0.0002742481756762073 : (i == 6) ? 5.318295896944988e-05 : 1.031338537721246e-05;
            const float ang = (float)pos * (float)f;
            double rev = (double)ang * 0.15915494309189535; rev -= floor(rev);
            const float rv = (float)rev;
            R[pos * 16 + i] = __builtin_amdgcn_cosf(rv); R[pos * 16 + 8 + i] = __builtin_amdgcn_sinf(rv);
        }
    }
    {
        float* C = (float*)(ws + WS_LRC);
        for (int idx = gw * 64 + lane; idx < 6 * 1024; idx += ngw * 64) {
            const int k = idx >> 10, ch = idx & 1023;
            const float* src = (k == 0) ? a.in[23] : (k == 1) ? a.in[25] : (k == 2) ? a.in[26] : (k == 3) ? a.in[28] : (k == 4) ? a.in[30] : a.in[31];
            const float v = src[ch];
            C[idx] = (k == 2 || k == 5) ? (-8.0f * 1.4426950408889634f) * pg8::softplus_neg(v) : -1.4426950408889634f * v;
        }
    }
    convert_items(a, lds, 0, 4224, gw, ngw, wave, lane);
    bf16_t* XB = (bf16_t*)(ws + WS_XB); float* SSQ = (float*)(ws + WS_SSQ);
    for (int row = 2 * gw; row < T_TOK; row += 2 * ngw) {
        f32x4 v[2][4]; float s[2];
#pragma unroll
        for (int q = 0; q < 2; ++q) { const int rw = row + q; const float* src = (rw < SEQ) ? a.in[0] + (size_t)rw * DM : a.in[1] + (size_t)(rw - SEQ) * DM;
            const f32x4* xr = (const f32x4*)src + lane;
#pragma unroll
            for (int j = 0; j < 4; ++j) v[q][j] = xr[64 * j]; }
#pragma unroll
        for (int q = 0; q < 2; ++q) { s[q] = 0.f;
#pragma unroll
            for (int j = 0; j < 4; ++j) s[q] += (v[q][j][0] * v[q][j][0] + v[q][j][1] * v[q][j][1]) + (v[q][j][2] * v[q][j][2] + v[q][j][3] * v[q][j][3]);
            s[q] = wave_sum(s[q]); }
#pragma unroll
        for (int q = 0; q < 2; ++q) { const int rw = row + q; u32x2* bo = (u32x2*)(XB + (size_t)rw * DM) + lane;
#pragma unroll
            for (int j = 0; j < 4; ++j) { u32x2 w; w.x = cvt_pk_bf16(v[q][j][0], v[q][j][1]); w.y = cvt_pk_bf16(v[q][j][2], v[q][j][3]); bo[64 * j] = w; }
            if (lane < 16) SSQ[(size_t)rw * 16 + lane] = (lane == 0) ? s[q] : 0.f; }
    }
}

__device__ __forceinline__ void conv_gate0(bf16_t* Z, const float* cw, int gtid, int nthr) {
    const int c8 = (gtid & 63) * 8;
    f32x4 w[3][2];
#pragma unroll
    for (int j = 0; j < 3; ++j) { w[j][0] = *(const f32x4*)(cw + j * 512 + c8); w[j][1] = *(const f32x4*)(cw + j * 512 + c8 + 4); }
    for (int idx = gtid; idx < T_TOK * 64; idx += nthr) {
        const int row = idx >> 6, pos = row & (SEQ - 1);
        u32x4 uu[3], gc[3];
#pragma unroll
        for (int j = 0; j < 3; ++j) { const int t = pos + j - 1; const int rr = row + ((t < 0) ? 0 : (t >= SEQ) ? 0 : j - 1);
            const bf16_t* zr = Z + (size_t)rr * Z0W; uu[j] = *(const u32x4*)(zr + c8); gc[j] = *(const u32x4*)(zr + 512 + c8); }
        bf16_t* gp = Z + (size_t)row * Z0W + 1024 + c8;
        const u32x4 gb = *(const u32x4*)gp;
        float acc[8] = {0.f, 0.f, 0.f, 0.f, 0.f, 0.f, 0.f, 0.f};
#pragma unroll
        for (int j = 0; j < 3; ++j) {
            const int t = pos + j - 1; const float mk = (t >= 0 && t < SEQ) ? 1.f : 0.f;
            const f32x4 w0 = w[j][0] * mk, w1 = w[j][1] * mk;
            acc[0] += w0[0] * (bflo(uu[j].x) * bflo(gc[j].x)); acc[1] += w0[1] * (bfhi(uu[j].x) * bfhi(gc[j].x));
            acc[2] += w0[2] * (bflo(uu[j].y) * bflo(gc[j].y)); acc[3] += w0[3] * (bfhi(uu[j].y) * bfhi(gc[j].y));
            acc[4] += w1[0] * (bflo(uu[j].z) * bflo(gc[j].z)); acc[5] += w1[1] * (bfhi(uu[j].z) * bfhi(gc[j].z));
            acc[6] += w1[2] * (bflo(uu[j].w) * bflo(gc[j].w)); acc[7] += w1[3] * (bfhi(uu[j].w) * bfhi(gc[j].w));
        }
        u32x4 o;
        o.x = cvt_pk_bf16(bflo(gb.x) * acc[0], bfhi(gb.x) * acc[1]); o.y = cvt_pk_bf16(bflo(gb.y) * acc[2], bfhi(gb.y) * acc[3]);
        o.z = cvt_pk_bf16(bflo(gb.z) * acc[4], bfhi(gb.z) * acc[5]); o.w = cvt_pk_bf16(bflo(gb.w) * acc[6], bfhi(gb.w) * acc[7]);
        *(u32x4*)gp = o;
    }
}

__device__ __forceinline__ void conv1(const bf16_t* XP, bf16_t* XBC, const float* cw, const float* cb, int gtid, int nthr) {
    const int c8 = (gtid & 127) * 8;
    f32x4 w[4][2];
#pragma unroll
    for (int j = 0; j < 4; ++j) { w[j][0] = *(const f32x4*)(cw + j * 1024 + c8); w[j][1] = *(const f32x4*)(cw + j * 1024 + c8 + 4); }
    const f32x4 b0 = *(const f32x4*)(cb + c8), b1 = *(const f32x4*)(cb + c8 + 4);
    for (int idx = gtid; idx < T_TOK * 128; idx += nthr) {
        const int row = idx >> 7, pos = row & (SEQ - 1);
        u32x4 xv[4];
#pragma unroll
        for (int j = 0; j < 4; ++j) { const int t = pos + j - 2; const int rr = row + ((t < 0) ? 0 : (t >= SEQ) ? 0 : j - 2); xv[j] = *(const u32x4*)(XP + (size_t)rr * DM + c8); }
        float acc[8] = {b0[0], b0[1], b0[2], b0[3], b1[0], b1[1], b1[2], b1[3]};
#pragma unroll
        for (int j = 0; j < 4; ++j) {
            const int t = pos + j - 2; const float mk = (t >= 0 && t < SEQ) ? 1.f : 0.f;
            const f32x4 w0 = w[j][0] * mk, w1 = w[j][1] * mk;
            acc[0] += w0[0] * bflo(xv[j].x); acc[1] += w0[1] * bfhi(xv[j].x); acc[2] += w0[2] * bflo(xv[j].y); acc[3] += w0[3] * bfhi(xv[j].y);
            acc[4] += w1[0] * bflo(xv[j].z); acc[5] += w1[1] * bfhi(xv[j].z); acc[6] += w1[2] * bflo(xv[j].w); acc[7] += w1[3] * bfhi(xv[j].w);
        }
        u32x4 o; o.x = cvt_pk_bf16(acc[0], acc[1]); o.y = cvt_pk_bf16(acc[2], acc[3]); o.z = cvt_pk_bf16(acc[4], acc[5]); o.w = cvt_pk_bf16(acc[6], acc[7]);
        *(u32x4*)(XBC + (size_t)row * DM + c8) = o;
    }
}

__device__ __forceinline__ void lru_carry(const float* CS, float* H0, LAS unsigned char* lds, int tid) {
    LAS float* gP = (LAS float*)lds; LAS float* gS = gP + 512;
    const int grp = tid >> 5, c = tid & 31;
    for (int u = blockIdx.x; u < 3 * 2 * 32; u += gridDim.x) {
        const int b = u / 64, dir = (u >> 5) & 1, ch = (u & 31) * 32 + c;
        float P = 1.f, S = 0.f; float pv[16], sv[16];
#pragma unroll
        for (int i = 0; i < 16; ++i) { const int o = grp * 16 + i, chunk = b * 256 + (dir ? 255 - o : o);
            pv[i] = CS[(size_t)chunk * 4096 + (dir * 2) * 1024 + ch]; sv[i] = CS[(size_t)chunk * 4096 + (dir * 2 + 1) * 1024 + ch]; }
#pragma unroll
        for (int i = 0; i < 16; ++i) { S = pv[i] * S + sv[i]; P = pv[i] * P; }
        gP[tid] = P; gS[tid] = S;
        __syncthreads();
        float h = 0.f;
        for (int g2 = 0; g2 < grp; ++g2) h = gP[g2 * 32 + c] * h + gS[g2 * 32 + c];
#pragma unroll
        for (int i = 0; i < 16; ++i) { const int o = grp * 16 + i, chunk = b * 256 + (dir ? 255 - o : o);
            H0[(size_t)chunk * 2048 + dir * 1024 + ch] = h; h = pv[i] * h + sv[i]; }
        __syncthreads();
    }
}

__device__ __forceinline__ void lru_apply(const bf16_t* PF, const bf16_t* PB, bf16_t* SS, const bf16_t* GG, const float* H0, int gtid, int nthr) {
    for (int idx = gtid; idx < T_TOK * 128; idx += nthr) {
        const int row = idx >> 7, c8 = (idx & 127) * 8; const unsigned o = (unsigned)row * 1024u + (unsigned)c8;
        const u32x4 pf = *(const u32x4*)(PF + o), pb = *(const u32x4*)(PB + o), ss = *(const u32x4*)(SS + o), gg = *(const u32x4*)(GG + o);
        const float* h0 = H0 + ((unsigned)(row >> 6) * 2048u + (unsigned)c8);
        const f32x4 f0 = *(const f32x4*)h0, f1 = *(const f32x4*)(h0 + 4), b0 = *(const f32x4*)(h0 + 1024), b1 = *(const f32x4*)(h0 + 1028);
        u32x4 y;
        y.x = cvt_pk_bf16((bflo(ss.x) + bflo(pf.x) * f0[0] + bflo(pb.x) * b0[0]) * bflo(gg.x), (bfhi(ss.x) + bfhi(pf.x) * f0[1] + bfhi(pb.x) * b0[1]) * bfhi(gg.x));
        y.y = cvt_pk_bf16((bflo(ss.y) + bflo(pf.y) * f0[2] + bflo(pb.y) * b0[2]) * bflo(gg.y), (bfhi(ss.y) + bfhi(pf.y) * f0[3] + bfhi(pb.y) * b0[3]) * bfhi(gg.y));
        y.z = cvt_pk_bf16((bflo(ss.z) + bflo(pf.z) * f1[0] + bflo(pb.z) * b1[0]) * bflo(gg.z), (bfhi(ss.z) + bfhi(pf.z) * f1[1] + bfhi(pb.z) * b1[1]) * bfhi(gg.z));
        y.w = cvt_pk_bf16((bflo(ss.w) + bflo(pf.w) * f1[2] + bflo(pb.w) * b1[2]) * bflo(gg.w), (bfhi(ss.w) + bfhi(pf.w) * f1[3] + bfhi(pb.w) * b1[3]) * bfhi(gg.w));
        *(u32x4*)(SS + o) = y;
    }
}

__device__ __forceinline__ void final_norm(const bf16_t* XB, float* OUT, const float* gain, int gw, int ngw, int lane) {
    f32x4 gv[2];
#pragma unroll
    for (int j = 0; j < 2; ++j) gv[j] = ((const f32x4*)gain)[2 * lane + j];
    f32x4 gw2[2];
#pragma unroll
    for (int j = 0; j < 2; ++j) gw2[j] = ((const f32x4*)gain)[128 + 2 * lane + j];
    for (int row = gw; row < T_TOK; row += ngw) {
        const u32x4 w0 = *((const u32x4*)(XB + (size_t)row * DM) + lane), w1 = *((const u32x4*)(XB + (size_t)row * DM + 512) + lane);
        f32x4 v[4] = {{bflo(w0.x), bfhi(w0.x), bflo(w0.y), bfhi(w0.y)}, {bflo(w0.z), bfhi(w0.z), bflo(w0.w), bfhi(w0.w)},
                      {bflo(w1.x), bfhi(w1.x), bflo(w1.y), bfhi(w1.y)}, {bflo(w1.z), bfhi(w1.z), bflo(w1.w), bfhi(w1.w)}};
        float s = 0.f;
#pragma unroll
        for (int j = 0; j < 4; ++j) s += (v[j][0] * v[j][0] + v[j][1] * v[j][1]) + (v[j][2] * v[j][2] + v[j][3] * v[j][3]);
        s = wave_sum(s);
        const float rs = 1.0f / sqrtf(s * (1.0f / 1024.0f) + EPS);
        f32x4* o = (f32x4*)(OUT + (size_t)row * DM);
        o[2 * lane] = v[0] * rs * gv[0]; o[2 * lane + 1] = v[1] * rs * gv[1];
        o[128 + 2 * lane] = v[2] * rs * gw2[0]; o[128 + 2 * lane + 1] = v[3] * rs * gw2[1];
    }
}

constexpr int APITCH = 144, AROWS = 272;
__device__ __forceinline__ s16x4 vtr(const LAS unsigned char* p) { return __builtin_bit_cast(s16x4, __builtin_amdgcn_ds_read_tr16_b64_v4i16((LAS v4i16_t*)p)); }

#define ATT_DECODE(uu, h_, tokbase_, n0_) const int h_ = (uu) & 7; const int j_##h_ = (uu) >> 3; const int b_##h_ = j_##h_ >> 7, blk_##h_ = j_##h_ & 127; \
        const int tokbase_ = b_##h_ * SEQ + blk_##h_ / NBR; const int n0_ = (blk_##h_ % NBR) * 128;
#define ATT_LOAD(h_, tokbase_, n0_) do { _Pragma("unroll") for (int i = 0; i < 4; ++i) { const int n = (n0_) - 64 + srow + 64 * i; \
        if (n >= 0 && n < L) { const int tk_ = (tokbase_) + n * DIL; const size_t o_ = ((size_t)((tk_ >> 14) * 8 + (h_)) * SEQ + (tk_ & (SEQ - 1))) * 64 + 8 * sch; kreg[i] = *(const u32x4*)(KH + o_); vreg[i] = *(const u32x4*)(VH + o_); } \
        else { kreg[i] = (u32x4){0u, 0u, 0u, 0u}; vreg[i] = (u32x4){0u, 0u, 0u, 0u}; } } } while (0)
#define ATT_LOADQ(h_, tokbase_, n0_) do { const size_t qt_ = (size_t)((tokbase_) + ((n0_) + 16 * wid + fr) * DIL); const bf16_t* qp_ = Z + qt_ * Z0W + 1536 + 64 * (h_); \
        Qn0 = *(const bf16x8*)(qp_ + 8 * fq); Qn1 = *(const bf16x8*)(qp_ + 32 + 8 * fq); \
        if (!FIRST) { mln = *(const f32x2*)(ML + qt_ * 16 + 2 * (h_)); _Pragma("unroll") for (int dt = 0; dt < 4; ++dt) on[dt] = *(const f32x4*)(OACC + qt_ * 512 + 64 * (h_) + 16 * dt + 4 * fq); } } while (0)

#define ATT_REGS u32x4 (&kreg)[4], u32x4 (&vreg)[4], bf16x8& Qn0, bf16x8& Qn1, f32x4 (&on)[4], f32x2& mln
template <int DIL, bool FIRST>
__device__ __forceinline__ void attn_prefetch(bf16_t* Z, const bf16_t* KH, const bf16_t* VH, float* OACC, float* ML, int wid, int fr, int fq, int srow, int sch, ATT_REGS, int uu) {
    constexpr int L = SEQ / DIL, NBR = 128 / DIL;
    ATT_DECODE(uu, h0, tb0, n00) ATT_LOAD(h0, tb0, n00); ATT_LOADQ(h0, tb0, n00);
}
template <int DIL, bool FIRST, bool LAST>
__device__ __forceinline__ void attn_unit(LAS unsigned char* Ks, LAS unsigned char* Vs, bf16_t* Z, const bf16_t* KH, const bf16_t* VH, float* OACC, float* ML,
                                          int wid, int fr, int fq, int srow, int sch, ATT_REGS, int u, int un, bool hn) {
    constexpr int L = SEQ / DIL, NBR = 128 / DIL;
        __syncthreads();
#pragma unroll
        for (int i = 0; i < 4; ++i) { *(LAS u32x4*)(Ks + (srow + 64 * i) * APITCH + 16 * sch) = kreg[i]; *(LAS u32x4*)(Vs + (srow + 64 * i) * APITCH + 16 * sch) = vreg[i]; }
        __syncthreads();
        ATT_DECODE(u, h, tokbase, n0)
        const int qn = n0 + 16 * wid + fr; const size_t qtok = (size_t)(tokbase + qn * DIL);
        bf16_t* qp = Z + qtok * Z0W + 1536 + 64 * h;
        const bf16x8 Q0 = Qn0, Q1 = Qn1;
        float m_old = -1e30f, l_old = 0.f;
        f32x4 o[4];
        if (!FIRST) {
            m_old = mln[0]; l_old = mln[1];
#pragma unroll
            for (int dt = 0; dt < 4; ++dt) o[dt] = on[dt];
        } else {
#pragma unroll
            for (int dt = 0; dt < 4; ++dt) o[dt] = (f32x4){0.f, 0.f, 0.f, 0.f};
        }
        if (hn) { ATT_DECODE(un, h1, tb1, n01) ATT_LOAD(h1, tb1, n01); ATT_LOADQ(h1, tb1, n01); }
        f32x4 st[9];
#pragma unroll
        for (int jt = 0; jt < 9; ++jt) {
            const LAS unsigned char* kp = Ks + (16 * wid + 16 * jt + fr) * APITCH + 16 * fq;
            const bf16x8 k0 = *(const LAS bf16x8*)kp, k1 = *(const LAS bf16x8*)(kp + 64);
            f32x4 s = {0.f, 0.f, 0.f, 0.f};
            s = __builtin_amdgcn_mfma_f32_16x16x32_bf16(k0, Q0, s, 0, 0, 0);
            s = __builtin_amdgcn_mfma_f32_16x16x32_bf16(k1, Q1, s, 0, 0, 0);
            st[jt] = s;
        }
        const float C = 0.18033688011112042f;
        float mx = -1e30f;
        const bool edge = (n0 == 0) || (n0 + 192 > L);
        if (!edge) {
#pragma unroll
            for (int jt = 0; jt < 9; ++jt)
#pragma unroll
                for (int e = 0; e < 4; ++e) {
                    float s = st[jt][e];
                    if (jt == 0) { if (4 * fq + e - fr < 0) s = -__builtin_inff(); }
                    if (jt == 8) { if (4 * fq + e - fr > 0) s = -__builtin_inff(); }
                    st[jt][e] = s; mx = fmaxf(mx, s);
                }
        } else {
#pragma unroll
            for (int jt = 0; jt < 9; ++jt)
#pragma unroll
                for (int e = 0; e < 4; ++e) {
                    const int delta = -64 + 16 * jt + 4 * fq + e - fr, nk = qn + delta;
                    const bool valid = (delta >= -64) && (delta <= 64) && (nk >= 0) && (nk < L);
                    const float s = valid ? st[jt][e] : -__builtin_inff();
                    st[jt][e] = s; mx = fmaxf(mx, s);
                }
        }
        mx = fmaxf(mx, __shfl_xor(mx, 16)); mx = fmaxf(mx, __shfl_xor(mx, 32));
        const float m_new = fmaxf(m_old, mx * C); const float alpha = __builtin_amdgcn_exp2f(m_old - m_new);
        float ls = 0.f;
#pragma unroll
        for (int jt = 0; jt < 9; ++jt)
#pragma unroll
            for (int e = 0; e < 4; ++e) { const float p = __builtin_amdgcn_exp2f(__builtin_fmaf(st[jt][e], C, -m_new)); st[jt][e] = p; ls += p; }
        ls += __shfl_xor(ls, 16); ls += __shfl_xor(ls, 32);
        const float l_new = l_old * alpha + ls;
#pragma unroll
        for (int dt = 0; dt < 4; ++dt) o[dt] = o[dt] * alpha;
#pragma unroll
        for (int kk = 0; kk < 5; ++kk) {
            union { unsigned w[4]; bf16x8 v; } pf;
            pf.w[0] = cvt_pk_bf16(st[2 * kk][0], st[2 * kk][1]); pf.w[1] = cvt_pk_bf16(st[2 * kk][2], st[2 * kk][3]);
            if (kk < 4) { pf.w[2] = cvt_pk_bf16(st[2 * kk + 1][0], st[2 * kk + 1][1]); pf.w[3] = cvt_pk_bf16(st[2 * kk + 1][2], st[2 * kk + 1][3]); } else { pf.w[2] = 0u; pf.w[3] = 0u; }
            const LAS unsigned char* vp = Vs + (16 * wid + 32 * kk + 4 * fq + (fr >> 2)) * APITCH + 8 * (fr & 3);
            s16x4 tv[4][2];
#pragma unroll
            for (int dt = 0; dt < 4; ++dt) { tv[dt][0] = vtr(vp + 32 * dt); tv[dt][1] = vtr(vp + 32 * dt + 16 * APITCH); }
#pragma unroll
            for (int dt = 0; dt < 4; ++dt) {
                union { s16x4 h[2]; bf16x8 v; } af;
                af.h[0] = tv[dt][0]; af.h[1] = tv[dt][1];
                o[dt] = __builtin_amdgcn_mfma_f32_16x16x32_bf16(af.v, pf.v, o[dt], 0, 0, 0);
            }
        }
        if (LAST) {
            const float inv = 1.0f / l_new;
#pragma unroll
            for (int dt = 0; dt < 4; ++dt) { u32x2 w; w.x = cvt_pk_bf16(o[dt][0] * inv, o[dt][1] * inv); w.y = cvt_pk_bf16(o[dt][2] * inv, o[dt][3] * inv);
                *(u32x2*)(qp + 16 * dt + 4 * fq) = w; }
        } else {
#pragma unroll
            for (int dt = 0; dt < 4; ++dt) *(f32x4*)(OACC + qtok * 512 + 64 * h + 16 * dt + 4 * fq) = o[dt];
            if (fq == 0) *(f32x2*)(ML + qtok * 16 + 2 * h) = (f32x2){m_new, l_new};
        }
}

template <int DIL, bool FIRST, bool LAST>
__device__ __forceinline__ void attn_phase(LAS unsigned char* lds, bf16_t* Z, const bf16_t* KH, const bf16_t* VH, float* OACC, float* ML, int tid) {
    constexpr int NU = 3072;
    LAS unsigned char* Ks = lds; LAS unsigned char* Vs = lds + AROWS * APITCH;
    const int wid = __builtin_amdgcn_readfirstlane(tid >> 6), lane = tid & 63, fr = lane & 15, fq = lane >> 4;
    for (int i = tid; i < 16 * APITCH / 4; i += NTHREADS) ((LAS unsigned*)(Vs + 256 * APITCH))[i] = 0u;
    const int srow = tid >> 3, sch = tid & 7;
    u32x4 kA[4], vA[4], kB[4], vB[4]; bf16x8 QA0, QA1, QB0, QB1; f32x4 oA[4], oB[4]; f32x2 mA = {-1e30f, 0.f}, mB = {-1e30f, 0.f};
    const int G = gridDim.x; int u = blockIdx.x;
    if (u < NU) attn_prefetch<DIL, FIRST>(Z, KH, VH, OACC, ML, wid, fr, fq, srow, sch, kA, vA, QA0, QA1, oA, mA, u);
    if (u + G < NU) attn_prefetch<DIL, FIRST>(Z, KH, VH, OACC, ML, wid, fr, fq, srow, sch, kB, vB, QB0, QB1, oB, mB, u + G);
    for (; u < NU; u += 2 * G) {
        attn_unit<DIL, FIRST, LAST>(Ks, Vs, Z, KH, VH, OACC, ML, wid, fr, fq, srow, sch, kA, vA, QA0, QA1, oA, mA, u, u + 2 * G, u + 2 * G < NU);
        if (u + G < NU) attn_unit<DIL, FIRST, LAST>(Ks, Vs, Z, KH, VH, OACC, ML, wid, fr, fq, srow, sch, kB, vB, QB0, QB1, oB, mB, u + G, u + 3 * G, u + 3 * G < NU);
    }
    __syncthreads();
}
#undef ATT_DECODE
#undef ATT_LOAD
#undef ATT_LOADQ
#undef ATT_REGS

#define XB_TMO      128
#define XB_XCNT(j)  (256  + 64 * (j))
#define XB_XSUB(j)  (1280 + 64 * (j))
#define XB_XGEN(j)  (2304 + 64 * (j))
#define XB_TOP      3328
#define XB_TOPGEN   3392
#define XCD_BAR_WORDS 3456
#define XB_SPIN_CAP (1u << 18)

__device__ __forceinline__ unsigned xb_ld(unsigned* p)              { return __hip_atomic_load(p, __ATOMIC_RELAXED, __HIP_MEMORY_SCOPE_AGENT); }
__device__ __forceinline__ unsigned xb_add(unsigned* p, unsigned v) { return __hip_atomic_fetch_add(p, v, __ATOMIC_RELAXED, __HIP_MEMORY_SCOPE_AGENT); }
__device__ __forceinline__ unsigned xb_xcc_id() { return (unsigned)__builtin_amdgcn_s_getreg((3 << 11) | 20) & 0xFu; }
#define XB_SPIN(cond, bar) do { unsigned _sp = 0; while (cond) { __builtin_amdgcn_s_sleep(1); \
    if ((++_sp & 255u) == 0u) { if (xb_ld(&(bar)[XB_TMO])) break; if (_sp > XB_SPIN_CAP) { atomicAdd(&(bar)[XB_TMO], 1u); break; } } } } while (0)

struct XcdBarrier {
    unsigned* bar; unsigned x;
    volatile LAS unsigned* st;
};

__device__ __forceinline__ XcdBarrier xcd_barrier_post(unsigned* bar, volatile LAS unsigned* st) {
    XcdBarrier b; b.bar = bar; b.x = xb_xcc_id(); b.st = st;
    if (threadIdx.x == 0) (void)xb_add(&bar[XB_XCNT(b.x)], 1u);
    return b;
}
__device__ __forceinline__ void xcd_barrier_complete(unsigned* bar, unsigned x, unsigned& nloc, unsigned& nx) {
    const unsigned G = gridDim.x * gridDim.y * gridDim.z;
    unsigned sum, cnt, mine, sp = 0u;
    for (;;) {
        sum = 0u; cnt = 0u; mine = 0u;
#pragma unroll
        for (unsigned j = 0; j < 16; ++j) { const unsigned c = xb_ld(&bar[XB_XCNT(j)]); sum += c; cnt += (c > 0u) ? 1u : 0u; mine = (j == x) ? c : mine; }
        if (sum == G) break;
        __builtin_amdgcn_s_sleep(1);
        if ((++sp & 255u) == 0u) { if (xb_ld(&bar[XB_TMO])) break; if (sp > XB_SPIN_CAP) { atomicAdd(&bar[XB_TMO], 1u); break; } }
    }
    nloc = mine > 0u ? mine : 1u; nx = cnt > 0u ? cnt : 1u;
}

__device__ __forceinline__ void xcd_barrier(const XcdBarrier& b) {
    asm volatile("s_waitcnt vmcnt(0)" ::: "memory");
    __syncthreads();
    if (threadIdx.x == 0) {
        unsigned* bar = b.bar;
        __builtin_amdgcn_s_waitcnt(0);
        unsigned nloc = b.st[0], nx = b.st[1];
        if (nloc == 0u) { xcd_barrier_complete(bar, b.x, nloc, nx); b.st[0] = nloc; b.st[1] = nx; }
        const unsigned old = xb_add(&bar[XB_XSUB(b.x)], 1u);
        const unsigned gen = old / nloc;
        if (old + 1u == (gen + 1u) * nloc) {
            __builtin_amdgcn_fence(__ATOMIC_RELEASE, "agent");
            asm volatile("s_waitcnt vmcnt(0)" ::: "memory");
            const unsigned og = xb_add(&bar[XB_TOP], 1u);
            const unsigned tg = og / nx;
            if (og + 1u == (tg + 1u) * nx) xb_add(&bar[XB_TOPGEN], 1u);
            else XB_SPIN(xb_ld(&bar[XB_TOPGEN]) == tg, bar);
            __builtin_amdgcn_fence(__ATOMIC_ACQUIRE, "agent");
            xb_add(&bar[XB_XGEN(b.x)], 1u);
            asm volatile("s_waitcnt vmcnt(0)" ::: "memory");
        } else {
            XB_SPIN(xb_ld(&bar[XB_XGEN(b.x)]) == gen, bar);
            __builtin_amdgcn_fence(__ATOMIC_ACQUIRE, "agent");
            asm volatile("s_waitcnt vmcnt(0)" ::: "memory");
        }
    }
    __syncthreads();
}

__device__ __forceinline__ void build_rstd_table(const pg8::StaticOrder& S, const float* SSQ, LAS unsigned char* lds, int tid) {
    LAS int* PML = (LAS int*)(lds + RING_BYTES + 512); LAS float* RT = (LAS float*)(lds + RING_BYTES + 1024);
    if (tid == 0) {
        int n = 0; pg8::Unit u;
        for (int i = 0; S.next(i, u); ++i) { bool f = false; for (int k = 0; k < n; ++k) f = f || (PML[k] == u.pm); if (!f && n < 8) PML[n++] = u.pm; }
        for (int k = n; k < 8; ++k) PML[k] = -1;
    }
    __syncthreads();
    for (int idx = tid; idx < 8 * 256; idx += NTHREADS) { const int pm = PML[idx >> 8]; if (pm >= 0) RT[idx] = pg8::row_rstd(SSQ, pm * 256 + (idx & 255)); }
    __syncthreads();
}

constexpr int NPHASES = 21;
__global__ void __launch_bounds__(NTHREADS, 2) trunk_fwd(Args args) {
    extern __shared__ __attribute__((aligned(16))) unsigned char lds_raw[];
    LAS unsigned char* lds = (LAS unsigned char*)lds_raw;
    const int tid = threadIdx.x, wave = __builtin_amdgcn_readfirstlane(tid >> 6);
#define lane (tid & 63)
    const int G = gridDim.x, bx = blockIdx.x;
#define gw (bx * NWAVES + wave)
#define ngw (G * NWAVES)
#define gtid (bx * NTHREADS + tid)
#define nthr (G * NTHREADS)
    unsigned char* ws = args.ws;
    float* X = args.out; bf16_t* XB = (bf16_t*)(ws + WS_XB); float* SSQ = (float*)(ws + WS_SSQ);
    bf16_t* BIG = (bf16_t*)(ws + WS_BIG);
    const int lo = args.ph_lo, hi = args.ph_hi;
    unsigned* barw = (unsigned*)ws;
    if (lo == 0) { if (bx == 0) for (int i = tid; i < XCD_BAR_WORDS; i += NTHREADS) barw[i] = 0u; }
    if (tid < 16) ((LAS unsigned*)(lds + RING_BYTES))[tid + 16] = 0u;
    __syncthreads();
    XcdBarrier bar; bar.bar = barw; bar.x = 0; bar.st = (volatile LAS unsigned*)(lds + RING_BYTES + 64);
#ifndef PH_MASK
#define PH_MASK 0x1fffff
#endif
#define IN(k) (((PH_MASK >> (k)) & 1) && lo <= (k) && (k) < hi)
#define GSYNC() xcd_barrier(bar)
#define SEAM(k) do { if (IN(k) && IN((k) + 1)) { if ((k) == 0) { cg::this_grid().sync(); bar = xcd_barrier_post(barw, (volatile LAS unsigned*)(lds + RING_BYTES + 64)); } else { GSYNC(); } } } while (0)
#define RT_PTR ((const LAS float*)(lds + RING_BYTES + 1024))
#define PML_PTR ((const LAS int*)(lds + RING_BYTES + 512))
#define GEMM_PHASE_RS(EPI, g_, e_) do { pg8::StaticOrder S_; S_.init((g_).M, (g_).N, G, bx); build_rstd_table(S_, SSQ, lds, tid); pg8::gemm_phase<EPI, pg8::StaticOrder, true, true>(lds, g_, S_, e_); } while (0)
#define GEMM_PHASE(EPI, g_, e_) do { pg8::StaticOrder S_; S_.init((g_).M, (g_).N, G, bx); pg8::gemm_phase<EPI, pg8::StaticOrder, true, true>(lds, g_, S_, e_); } while (0)

#ifndef REP_MASK
#define REP_MASK 0
#endif
#define RUNPH(k, DRY, REAL) if (IN(k)) { if ((REP_MASK >> (k)) & 1) { DRY; if ((k) == 0) cg::this_grid().sync(); else GSYNC(); } REAL; } SEAM(k);
    RUNPH(0, prologue(args, lds, gw, ngw, wave, lane), prologue(args, lds, gw, ngw, wave, lane))
#define FFN_UP_BODY(f) { pg8::Gemm g{XB, (const bf16_t*)(ws + WS_W + (f) * WS_FFN_STRIDE + WS_W1T_OFF), T_TOK, 2 * DFF, DM, DM, 30, 0}; \
        pg8::EpiGateUp E{BIG, SSQ, RT_PTR, PML_PTR}; GEMM_PHASE_RS(pg8::EpiGateUp, g, E); }
#define FFN_DOWN_BODY(f, sc) { pg8::Gemm g{BIG, (const bf16_t*)(ws + WS_W + (f) * WS_FFN_STRIDE + WS_W2T_OFF), T_TOK, DM, DFF, DFF, 30, 0}; \
        pg8::EpiResid E{XB, SSQ, sc, nullptr, nullptr}; GEMM_PHASE(pg8::EpiResid, g, E); }
#define LATE_CONVERT(lo1, hi1, lo2, hi2) if (bx >= G / 2) { const int w_ = (bx - G / 2) * NWAVES + wave, nw_ = (G - G / 2) * NWAVES; \
        convert_items(args, lds, lo1, hi1, w_, nw_, wave, lane); convert_items(args, lds, lo2, hi2, w_, nw_, wave, lane); }
#define FFN_UP(k, f) RUNPH(k, FFN_UP_BODY(f), FFN_UP_BODY(f))
#define FFN_DOWN(k, f) RUNPH(k, FFN_DOWN_BODY(f, 0.0f), FFN_DOWN_BODY(f, 0.5f))
#define FFN_DOWN0_BODY(sc) { pg8::Gemm g{BIG, (const bf16_t*)(ws + WS_W + WS_W2T_OFF), T_TOK, DM, DFF, DFF, 30, 0}; \
        pg8::EpiResidIn E{XB, SSQ, sc, args.in[0], args.in[1]}; GEMM_PHASE(pg8::EpiResidIn, g, E); }
    RUNPH(1, FFN_UP_BODY(0), { FFN_UP_BODY(0) LATE_CONVERT(4224, 8448, 16896, 18944) })
    RUNPH(2, FFN_DOWN0_BODY(0.0f), FFN_DOWN0_BODY(0.5f))
    bf16_t* AKH = (bf16_t*)X + (size_t)T_TOK * DM; bf16_t* AVH = AKH + (size_t)T_TOK * 512;
#define WIN0_BODY { pg8::Gemm g{XB, (const bf16_t*)(ws + WS_L0WIN), T_TOK, Z0W, DM, DM, 30, 0}; pg8::EpiZ0 E{BIG, SSQ, RT_PTR, PML_PTR, (const float*)(ws + WS_ROPE), AKH, AVH}; GEMM_PHASE_RS(pg8::EpiZ0, g, E); }
    RUNPH(3, WIN0_BODY, WIN0_BODY)
#define ATT1_BODY attn_phase<1, true, false>(lds, BIG, AKH, AVH, X, (float*)(ws + WS_ML), tid);
    RUNPH(4, ATT1_BODY, { conv_gate0(BIG, args.in[8], gtid, nthr); ATT1_BODY })
    if (IN(5)) attn_phase<4, false, false>(lds, BIG, AKH, AVH, X, (float*)(ws + WS_ML), tid);
    SEAM(5);
    if (IN(6)) attn_phase<16, false, true>(lds, BIG, AKH, AVH, X, (float*)(ws + WS_ML), tid);
    SEAM(6);
#define WOUT0_BODY(sc) { pg8::Gemm g{BIG + 1024, (const bf16_t*)(ws + WS_L0WOUT), T_TOK, DM, DM, Z0W, 30, 0}; pg8::EpiResid E{XB, SSQ, sc, nullptr, nullptr}; GEMM_PHASE(pg8::EpiResid, g, E); }
    RUNPH(7, WOUT0_BODY(0.0f), WOUT0_BODY(1.0f))
    RUNPH(8, FFN_UP_BODY(1), { FFN_UP_BODY(1) LATE_CONVERT(8448, 12672, 18944, 20992) }) FFN_DOWN(9, 1)
    RUNPH(10, FFN_UP_BODY(2), { FFN_UP_BODY(2) LATE_CONVERT(12672, 16896, 0, 0) }) FFN_DOWN(11, 2)
    bf16_t* XP = BIG; bf16_t* GG = BIG + (size_t)T_TOK * DM; bf16_t* XBC = BIG + 2 * (size_t)T_TOK * DM; bf16_t* Y1 = XP;
#define WIN1_BODY { pg8::Gemm g{XB, (const bf16_t*)(ws + WS_L1WIN), T_TOK, 2048, DM, DM, 30, 0}; pg8::EpiZ1 E{XP, GG, SSQ, RT_PTR, PML_PTR}; GEMM_PHASE_RS(pg8::EpiZ1, g, E); }
    RUNPH(12, WIN1_BODY, WIN1_BODY)
#define CONV1_BODY conv1(XP, XBC, args.in[20], args.in[21], gtid, nthr);
    RUNPH(13, CONV1_BODY, CONV1_BODY)
    bf16_t* LPF = XP; bf16_t* LPB = (bf16_t*)X; bf16_t* LSS = (bf16_t*)X + (size_t)T_TOK * DM;
    float* LCS = (float*)(ws + WS_W); float* LH0 = (float*)(ws + WS_W + 17 * MiB);
#define LRU_BODY { pg8::Gemm g{XBC, (const bf16_t*)(ws + WS_GATES), T_TOK, 4096, 256, DM, 2, 512}; \
        const float* LRC = (const float*)(ws + WS_LRC); pg8::EpiLru E{XBC, LPF, LPB, LSS, LCS, LRC, LRC + 1024, LRC + 2048, LRC + 3072, LRC + 4096, LRC + 5120}; GEMM_PHASE(pg8::EpiLru, g, E); }
    RUNPH(14, LRU_BODY, LRU_BODY)
#define CARRY_BODY lru_carry(LCS, LH0, lds, tid);
    RUNPH(15, CARRY_BODY, CARRY_BODY)
    if (IN(16)) lru_apply(LPF, LPB, LSS, GG, LH0, gtid, nthr);
    SEAM(16);
    Y1 = LSS;
#define WOUT1_BODY(sc) { pg8::Gemm g{Y1, (const bf16_t*)(ws + WS_L1WOUT), T_TOK, DM, DM, DM, 30, 0}; pg8::EpiResid E{XB, SSQ, sc, nullptr, nullptr}; GEMM_PHASE(pg8::EpiResid, g, E); }
    RUNPH(17, WOUT1_BODY(0.0f), WOUT1_BODY(1.0f))
    FFN_UP(18, 3) FFN_DOWN(19, 3)
    if (IN(20)) final_norm(XB, X, args.in[37], gw, ngw, lane);
#undef lane
#undef gw
#undef ngw
#undef gtid
#undef nthr
#undef IN
#undef SEAM
}

extern "C" void kernel_launch(void* const* d_in, const int* in_sizes, int n_in, void* d_out, int out_size, void* d_ws, size_t ws_size, hipStream_t stream) {
    static int grid = 0;
    if (grid == 0) {
        if (n_in != 38 || out_size != T_TOK * DM || ws_size < WS_END) { fprintf(stderr, "kernel_launch: unexpected shapes (n_in %d, out %d, ws %zu); nothing launched\n", n_in, out_size, ws_size); grid = -1; return; }
        int dev = 0, cus = 0, per_cu = 0;
        if (hipGetDevice(&dev) != hipSuccess || hipDeviceGetAttribute(&cus, hipDeviceAttributeMultiprocessorCount, dev) != hipSuccess) { grid = -1; return; }
        if (hipFuncSetAttribute((const void*)trunk_fwd, hipFuncAttributeMaxDynamicSharedMemorySize, LDS_BYTES) != hipSuccess) { fprintf(stderr, "kernel_launch: hipFuncSetAttribute failed\n"); grid = -1; return; }
        if (hipOccupancyMaxActiveBlocksPerMultiprocessor(&per_cu, (const void*)trunk_fwd, NTHREADS, LDS_BYTES) != hipSuccess || per_cu < 1) { fprintf(stderr, "kernel_launch: occupancy query says %d\n", per_cu); per_cu = 1; }
        (void)hipGetLastError();
        grid = cus * per_cu;
    }
    if (grid < 0) return;
    Args a{};
    for (int i = 0; i < 38; ++i) a.in[i] = (const float*)d_in[i];
    a.out = (float*)d_out; a.ws = (unsigned char*)d_ws;
#if MK_N_LAUNCHES == 1
    a.ph_lo = 0; a.ph_hi = NPHASES;
    void* kargs[] = {&a};
    hipError_t e = hipLaunchCooperativeKernel((const void*)trunk_fwd, dim3(grid), dim3(NTHREADS), kargs, LDS_BYTES, stream);
    if (e != hipSuccess) fprintf(stderr, "cooperative launch failed: %s (grid %d)\n", hipGetErrorString(e), grid);
#else
    for (int k = 0; k < NPHASES; ++k) {
        a.ph_lo = k; a.ph_hi = k + 1;
        hipLaunchKernelGGL(trunk_fwd, dim3(grid), dim3(NTHREADS), LDS_BYTES, stream, a);
    }
#endif
}
```
